# Optimizing an MI355X kernel written in HIP

```python
import math
import jax, jax.numpy as jnp
from jax import lax
import numpy as np

D_MODEL = 1024
BATCH = 4
SEQ = 4096
DEPTH = 1

DN_HEADS = 8
DN_HEAD_DIM = 128
DN_WIDTH = DN_HEADS * DN_HEAD_DIM
CONV_K = 5
CHUNK = 64
MLA_HEADS = 8
Q_LORA = 512
KV_LORA = 256
NOPE_DIM = 128
ROPE_DIM = 64
V_DIM = 128
QK_DIM = NOPE_DIM + ROPE_DIM
MLA_WIDTH = MLA_HEADS * V_DIM
ROPE_THETA = 10000.0
Q_BLOCK = 128
N_EXPERTS = 16
CAPACITY_FACTOR = 2
D_EXPERT = 1024
N_BRANCHES = 2
N_MOD = 6
EPS = 1e-6

IN_SPLITS = (3 * DN_WIDTH,
             DN_WIDTH,
             2 * DN_HEADS,
             2 * DN_HEADS,
             Q_LORA,
             KV_LORA,
             ROPE_DIM,
             N_BRANCHES * D_MODEL)
N_IN = sum(IN_SPLITS)

kernel_name = 'hybrid_gdn_mla_ec_block'


def rms_norm(x, g):
    xf = x.astype(jnp.float32)
    y = xf * lax.rsqrt(jnp.mean(xf * xf, axis=-1, keepdims=True) + EPS)
    return (y * g.astype(jnp.float32)).astype(x.dtype)


def l2_norm(x):
    return x * lax.rsqrt(jnp.sum(x * x, axis=-1, keepdims=True) + EPS)


def apply_rope(x, cos, sin):
    x1, x2 = jnp.split(x.astype(jnp.float32), 2, axis=-1)
    return jnp.concatenate([x1 * cos - x2 * sin, x2 * cos + x1 * sin], axis=-1).astype(x.dtype)


def centred_depthwise_conv(x, w):
    ch = x.shape[-1]
    pad = (CONV_K - 1) // 2
    return lax.conv_general_dilated(x, w[:, None, :].astype(x.dtype), window_strides=(1,),
                                    padding=[(pad, pad)], dimension_numbers=('NWC', 'WIO', 'NWC'),
                                    feature_group_count=ch)


def chunk_gated_delta_rule(q, k, v, g, beta):
    b, h, s, dk = k.shape
    dv = v.shape[-1]
    nc = s // CHUNK
    q = q * (dk ** -0.5)
    qc = q.reshape(b, h, nc, CHUNK, dk)
    kc = k.reshape(b, h, nc, CHUNK, dk)
    vc = v.reshape(b, h, nc, CHUNK, dv)
    bc = beta.reshape(b, h, nc, CHUNK)
    gc = jnp.cumsum(g.reshape(b, h, nc, CHUNK), axis=-1)
    tril = jnp.tril(jnp.ones((CHUNK, CHUNK), dtype=bool))
    strict = jnp.tril(jnp.ones((CHUNK, CHUNK), dtype=bool), -1)
    diff = gc[..., :, None] - gc[..., None, :]
    decay = jnp.where(tril, jnp.exp(jnp.where(tril, diff, 0.0)), 0.0)
    k_beta = kc * bc[..., None]
    v_beta = vc * bc[..., None]
    lower = jnp.where(strict, jnp.einsum('bhnik,bhnjk->bhnij', k_beta, kc) * decay, 0.0)
    eye = jnp.eye(CHUNK, dtype=jnp.float32)
    t_inv = lax.linalg.triangular_solve(eye + lower, jnp.broadcast_to(eye, lower.shape),
                                        left_side=True, lower=True, unit_diagonal=True)
    u = t_inv @ v_beta
    w = t_inv @ (k_beta * jnp.exp(gc)[..., None])
    intra = jnp.where(tril, jnp.einsum('bhnik,bhnjk->bhnij', qc, kc) * decay, 0.0)
    q_dec = qc * jnp.exp(gc)[..., None]
    g_last = gc[..., -1]
    k_state = kc * jnp.exp(g_last[..., None] - gc)[..., None]

    def step(state, xs):
        w_i, u_i, intra_i, qd_i, ks_i, gl_i = xs
        v_new = u_i - w_i @ state
        o_i = qd_i @ state + intra_i @ v_new
        state = state * jnp.exp(gl_i)[..., None, None] + jnp.swapaxes(ks_i, -1, -2) @ v_new
        return state, o_i

    xs = tuple(jnp.moveaxis(t, 2, 0) for t in (w, u, intra, q_dec, k_state, g_last))
    state0 = jnp.zeros((b, h, dk, dv), jnp.float32)
    _, o = lax.scan(step, state0, xs)
    return jnp.moveaxis(o, 0, 2).reshape(b, h, s, dv)


def gated_deltanet_branch(qkv, z, b_in, a_in, conv_w, a_log, dt_bias, o_gain):
    bsz, s, _ = qkv.shape
    qkv = jax.nn.silu(centred_depthwise_conv(qkv, conv_w))
    q, k, v = jnp.split(qkv, 3, axis=-1)

    def heads(t):
        return t.reshape(bsz, s, DN_HEADS, DN_HEAD_DIM).transpose(0, 2, 1, 3).astype(jnp.float32)

    q, k, v = l2_norm(heads(q)), l2_norm(heads(k)), heads(v)
    beta = jax.nn.sigmoid(b_in.astype(jnp.float32)).reshape(bsz, s, 2, DN_HEADS).transpose(2, 0, 3, 1)
    a = a_in.astype(jnp.float32).reshape(bsz, s, 2, DN_HEADS)
    g = -jnp.exp(a_log.astype(jnp.float32)) * jax.nn.softplus(a + dt_bias.astype(jnp.float32))
    g = g.transpose(2, 0, 3, 1)
    o_fwd = chunk_gated_delta_rule(q, k, v, g[0], beta[0])
    flip = lambda t: jnp.flip(t, axis=2)
    o_bwd = flip(chunk_gated_delta_rule(flip(q), flip(k), flip(v), flip(g[1]), flip(beta[1])))
    o = (o_fwd + o_bwd).transpose(0, 2, 1, 3)
    zf = z.astype(jnp.float32).reshape(bsz, s, DN_HEADS, DN_HEAD_DIM)
    o = rms_norm(o, o_gain) * jax.nn.silu(zf)
    return o.reshape(bsz, s, DN_WIDTH).astype(qkv.dtype)


def mla_branch(c_q, c_kv, k_r, q_gain, w_uq, kv_gain, w_ukv, cos, sin):
    bsz, s, _ = c_q.shape
    q = (rms_norm(c_q, q_gain) @ w_uq).reshape(bsz, s, MLA_HEADS, QK_DIM)
    q = jnp.concatenate([q[..., :NOPE_DIM],
                         apply_rope(q[..., NOPE_DIM:], cos[:, :, None], sin[:, :, None])], axis=-1)
    kv = (rms_norm(c_kv, kv_gain) @ w_ukv).reshape(bsz, s, MLA_HEADS, NOPE_DIM + V_DIM)
    k_nope, v = kv[..., :NOPE_DIM], kv[..., NOPE_DIM:]
    k_rope = apply_rope(k_r, cos, sin)
    k = jnp.concatenate([k_nope, jnp.broadcast_to(k_rope[:, :, None], (bsz, s, MLA_HEADS, ROPE_DIM))], axis=-1)
    qb = (q * (QK_DIM ** -0.5)).reshape(bsz, s // Q_BLOCK, Q_BLOCK, MLA_HEADS, QK_DIM).transpose(1, 0, 2, 3, 4)

    def attend(q_blk):
        scores = jnp.einsum('bqhd,bkhd->bhqk', q_blk, k, preferred_element_type=jnp.float32)
        p = jax.nn.softmax(scores, axis=-1)
        return jnp.einsum('bhqk,bkhd->bqhd', p.astype(v.dtype), v)

    o = lax.map(attend, qb)
    return o.transpose(1, 0, 2, 3, 4).reshape(bsz, s, MLA_WIDTH)


def expert_choice_ffn(h, w_router, w_gate, w_up, w_down):
    bsz, s, d = h.shape
    cap = CAPACITY_FACTOR * s // N_EXPERTS
    aff = jax.nn.softmax((h @ w_router).astype(jnp.float32), axis=-1)
    gate, idx = lax.top_k(aff.transpose(0, 2, 1), cap)
    idx_flat = idx.reshape(bsz, N_EXPERTS * cap)
    xe = jnp.take_along_axis(h, idx_flat[..., None], axis=1).reshape(bsz, N_EXPERTS, cap, d)
    hid = jax.nn.silu(jnp.einsum('becd,edf->becf', xe, w_gate)) * jnp.einsum('becd,edf->becf', xe, w_up)
    ye = jnp.einsum('becf,efd->becd', hid, w_down) * gate[..., None].astype(h.dtype)
    out = jnp.zeros_like(h).at[jnp.arange(bsz)[:, None], idx_flat].add(ye.reshape(bsz, N_EXPERTS * cap, d))
    return out


def setup_inputs(seed: int = 0) -> dict:
    key = jax.random.key(seed)
    ks = jax.random.split(key, 24)
    f32 = jnp.float32

    def nrm(k, shape, fan_in):
        return jax.random.normal(k, shape, f32) * (fan_in ** -0.5)

    def gain(k, shape):
        return 1.0 + 0.05 * jax.random.normal(k, shape, f32)

    x = jax.random.normal(ks[0], (BATCH, SEQ, D_MODEL), f32)
    c = jax.random.normal(ks[1], (BATCH, D_MODEL), f32)
    positions = (jnp.cumsum(jax.random.randint(ks[2], (BATCH, SEQ), 1, 3), axis=1) - 1).astype(jnp.int32)
    w_mod = 0.5 * nrm(ks[3], (DEPTH, D_MODEL, N_MOD * D_MODEL), D_MODEL)
    b_mod = 0.02 * jax.random.normal(ks[4], (DEPTH, N_MOD * D_MODEL), f32)
    g_mix = gain(ks[5], (DEPTH, D_MODEL))
    w_in = nrm(ks[6], (DEPTH, D_MODEL, N_IN), D_MODEL)
    conv_w = nrm(ks[7], (DEPTH, CONV_K, 3 * DN_WIDTH), CONV_K)
    a_log = jnp.log(jax.random.uniform(ks[8], (DEPTH, 2, DN_HEADS), f32, 1.0, 16.0))
    dt = jnp.exp(jax.random.uniform(ks[9], (DEPTH, 2, DN_HEADS), f32, math.log(1e-3), math.log(1e-1)))
    dt_bias = dt + jnp.log(-jnp.expm1(-dt))
    dn_o_gain = gain(ks[10], (DEPTH, DN_HEAD_DIM))
    q_gain = gain(ks[11], (DEPTH, Q_LORA))
    w_uq = nrm(ks[12], (DEPTH, Q_LORA, MLA_HEADS * QK_DIM), Q_LORA)
    kv_gain = gain(ks[13], (DEPTH, KV_LORA))
    w_ukv = nrm(ks[14], (DEPTH, KV_LORA, MLA_HEADS * (NOPE_DIM + V_DIM)), KV_LORA)
    w_o_dn = nrm(ks[15], (DEPTH, DN_WIDTH, D_MODEL), DN_WIDTH)
    w_o_mla = nrm(ks[16], (DEPTH, MLA_WIDTH, D_MODEL), MLA_WIDTH)
    w_out = nrm(ks[17], (DEPTH, D_MODEL, D_MODEL), D_MODEL)
    g_ffn = gain(ks[18], (DEPTH, D_MODEL))
    w_router = nrm(ks[19], (DEPTH, D_MODEL, N_EXPERTS), D_MODEL)
    w_gate = nrm(ks[20], (DEPTH, N_EXPERTS, D_MODEL, D_EXPERT), D_MODEL)
    w_up = nrm(ks[21], (DEPTH, N_EXPERTS, D_MODEL, D_EXPERT), D_MODEL)
    w_down = nrm(ks[22], (DEPTH, N_EXPERTS, D_EXPERT, D_MODEL), D_EXPERT)
    g_final = gain(ks[23], (D_MODEL,))
    return {'x': x, 'c': c, 'positions': positions, 'w_mod': w_mod, 'b_mod': b_mod, 'g_mix': g_mix,
            'w_in': w_in, 'conv_w': conv_w, 'a_log': a_log, 'dt_bias': dt_bias, 'dn_o_gain': dn_o_gain,
            'q_gain': q_gain, 'w_uq': w_uq, 'kv_gain': kv_gain, 'w_ukv': w_ukv, 'w_o_dn': w_o_dn,
            'w_o_mla': w_o_mla, 'w_out': w_out, 'g_ffn': g_ffn, 'w_router': w_router, 'w_gate': w_gate,
            'w_up': w_up, 'w_down': w_down, 'g_final': g_final}


def reference(x, c, positions, w_mod, b_mod, g_mix, w_in, conv_w, a_log, dt_bias, dn_o_gain,
              q_gain, w_uq, kv_gain, w_ukv, w_o_dn, w_o_mla, w_out, g_ffn, w_router, w_gate,
              w_up, w_down, g_final):
    half = ROPE_DIM // 2
    inv_freq = ROPE_THETA ** (-jnp.arange(half, dtype=jnp.float32) / half)
    ang = positions.astype(jnp.float32)[..., None] * inv_freq
    cos, sin = jnp.cos(ang), jnp.sin(ang)
    split_at = np.cumsum(IN_SPLITS)[:-1].tolist()
    for l in range(DEPTH):
        mod = jax.nn.silu(c) @ w_mod[l] + b_mod[l]
        sh1, sc1, gt1, sh2, sc2, gt2 = jnp.split(mod[:, None, :], N_MOD, axis=-1)
        h = rms_norm(x, g_mix[l]) * (1.0 + sc1) + sh1
        proj = h @ w_in[l]
        dn_qkv, dn_z, dn_b, dn_a, c_q, c_kv, k_r, gates = jnp.split(proj, split_at, axis=-1)
        y_dn = gated_deltanet_branch(dn_qkv, dn_z, dn_b, dn_a, conv_w[l], a_log[l], dt_bias[l],
                                     dn_o_gain[l]) @ w_o_dn[l]
        y_mla = mla_branch(c_q, c_kv, k_r, q_gain[l], w_uq[l], kv_gain[l], w_ukv[l], cos, sin) @ w_o_mla[l]
        g_dn, g_mla = jnp.split(jax.nn.sigmoid(gates), N_BRANCHES, axis=-1)
        merged = g_dn * y_dn + g_mla * y_mla
        x = x + gt1 * (merged @ w_out[l])
        h = rms_norm(x, g_ffn[l]) * (1.0 + sc2) + sh2
        x = x + gt2 * expert_choice_ffn(h, w_router[l], w_gate[l], w_up[l], w_down[l])
    return rms_norm(x, g_final)
```

```cpp
#include <hip/hip_runtime.h>
#include <cstdio>
#include <cstdint>
#ifndef MK_PER_PHASE
#define MK_PER_PHASE 0
#endif
#ifndef PROBE_MASK
#define PROBE_MASK 0x0u
#endif
#ifndef PROBE_VARIANT
#define PROBE_VARIANT 0x0
#endif
namespace pg8 {
#define PG8_LAS __attribute__((address_space(3)))
typedef unsigned short bf16_t;
typedef short bf16x8 __attribute__((ext_vector_type(8)));
typedef float f32x4 __attribute__((ext_vector_type(4)));
typedef unsigned u32x4 __attribute__((ext_vector_type(4)));
constexpr int BM = 256, BK = 64, HALF = 128, HTB = HALF * BK * 2  , STAGE_BYTES = 8 * HTB, NXCD = 8, WGM = 8;

__host__ __device__ __forceinline__ int lds_byte(int r, int c) { const int st = (r >> 4) * 2 + (c >> 5), rr = r & 15, cc = c & 31, ob = rr * 64 + cc * 2; return st * 1024 + (ob ^ (((ob >> 9) & 1) << 5)); }
__host__ __device__ __forceinline__ void stage_rc(int b, int& R, int& C) { const int st = b / 1024, sb = b % 1024, swz = sb ^ (((sb >> 9) & 1) << 5); R = (st >> 1) * 16 + swz / 64; C = (st & 1) * 32 + (swz % 64) / 2; }
__host__ __device__ __forceinline__ int perm32(int rho) { const int n = rho >> 4, i = rho & 15; return 8 * (i >> 2) + 4 * n + (i & 3); }

struct Unit { int pm, pn, z; };
struct Gemm { const bf16_t* A; const bf16_t* Bt; int M, N, K; const int* arow = nullptr; const bf16_t* A2 = nullptr; const bf16_t* Bt2 = nullptr; };

struct StaticOrder {
    int nM, nN, nwg, G, c, reps;
    __host__ __device__ void init(int M, int N, int G_, int c_, int reps_ = 1) { nM = M / BM; nN = N / BM; nwg = nM * nN; G = G_; c = c_; reps = reps_; }
    __host__ __device__ bool next(int i, Unit& u) const {
        if (reps > 1) { const int per = (nwg - c + G - 1) / G; if (i >= per * reps) return false; i %= per; }
        const long L = (long)i * G + c; if (L >= nwg) return false;
        int wgid = (int)L; { const int q = nwg / NXCD, r = nwg % NXCD, xcd = wgid % NXCD, off = wgid / NXCD; wgid = (xcd < r ? xcd * (q + 1) : r * (q + 1) + (xcd - r) * q) + off; }
        const int nig = WGM * nN, gid = wgid / nig, fm = gid * WGM, gsz = (nM - fm) < WGM ? (nM - fm) : WGM;
        u.pm = fm + ((wgid % nig) % gsz); u.pn = (wgid % nig) / gsz; u.z = 0; return true;
    }
    __device__ __forceinline__ void a_ready(const Unit&) const {}
    __device__ __forceinline__ void done(const Unit&) const {}
};

typedef float f32x2 __attribute__((ext_vector_type(2)));
typedef __bf16 bf16x2_c __attribute__((ext_vector_type(2)));
__device__ __forceinline__ unsigned cvt_pk_bf16(float lo, float hi) { f32x2 v = {lo, hi}; bf16x2_c b2 = __builtin_convertvector(v, bf16x2_c); return __builtin_bit_cast(unsigned, b2); }
template <class Epi, class Sched, bool ALIGN_EPI = false, bool SP2 = false, bool GATHER = false>
__device__ __forceinline__ void gemm_phase(PG8_LAS unsigned char* lds, const Gemm g, const Sched& S, const Epi& E) {
    const int tid = threadIdx.x, wid = __builtin_amdgcn_readfirstlane(tid >> 6), lane = tid & 63, wr = wid >> 2, wc = wid & 3, fr = lane & 15, fq = lane >> 4;
    const int K = g.K, nt = K / BK;
    unsigned voffA[2], voffB[2];
#pragma unroll
    for (int i = 0; i < 2; ++i) { int R, C; stage_rc(tid * 16 + i * 8192, R, C); const int Rb = Epi::PERM ? ((R & ~31) + perm32(R & 31)) : R;
        voffA[i] = (unsigned)(R * K + C) * 2u; voffB[i] = (unsigned)(Rb * K + C) * 2u; }
    const size_t kstep = (size_t)(BK * 2);
    const size_t hstep = (size_t)HALF * K * 2;
    const size_t tstep = 2 * hstep;
    const unsigned ldsw = (unsigned)wid * 1024u;
    const int aoff = lds_byte(wr * 64 + fr, fq * 8), boff = lds_byte(wc * 32 + fr, fq * 8);
#define PG8_SA(b, h) (((b) * 2 + (h)) * HTB)
#define PG8_SB(b, h) ((4 + (b) * 2 + (h)) * HTB)
#define PG8_STAGE(bufoff, gbase, voff) do { _Pragma("unroll") for (int _i = 0; _i < 2; ++_i) \
        __builtin_amdgcn_global_load_lds((const unsigned*)((const char*)(gbase) + (voff)[_i]), (PG8_LAS unsigned*)(lds + (bufoff) + ldsw + _i * 8192), 16, 0, 0); } while (0)
#define PG8_LDA(dst, b, h) do { _Pragma("unroll") for (int m = 0; m < 4; ++m) _Pragma("unroll") for (int k = 0; k < 2; ++k) dst[m][k] = *(const PG8_LAS bf16x8*)(lds + PG8_SA(b, h) + aoff + m * 2048 + k * 1024); } while (0)
#define PG8_LDB(dst, b, h) do { _Pragma("unroll") for (int n = 0; n < 2; ++n) _Pragma("unroll") for (int k = 0; k < 2; ++k) dst[n][k] = *(const PG8_LAS bf16x8*)(lds + PG8_SB(b, h) + boff + n * 2048 + k * 1024); } while (0)
#define PG8_MMA(ai, bj, At, Bt) do { __builtin_amdgcn_s_setprio(1); _Pragma("unroll") for (int m = 0; m < 4; ++m) _Pragma("unroll") for (int n = 0; n < 2; ++n) _Pragma("unroll") for (int k = 0; k < 2; ++k) \
        acc[ai][bj][m][n] = __builtin_amdgcn_mfma_f32_16x16x32_bf16(Bt[n][k], At[m][k], acc[ai][bj][m][n], 0, 0, 0); __builtin_amdgcn_s_setprio(0); } while (0)
#define PG8_WAIT_V(n) asm volatile("s_waitcnt vmcnt(" #n ")" ::: "memory")
#define PG8_WAIT_L(n) asm volatile("s_waitcnt lgkmcnt(" #n ")" ::: "memory")
#define PG8_BAR __builtin_amdgcn_s_barrier()
#define PG8_SCHED __builtin_amdgcn_sched_barrier(0)
    Unit cur, nxt; int ui = 0;
    if (!S.next(0, cur)) return;
    static_assert(!GATHER || SP2, "the gathered-A form exists for the SP2 loop only");
    unsigned vc0[2], vc1[2], vn0[2], vn1[2];
#define PG8_GOFFS(u_, o0_, o1_) do { _Pragma("unroll") for (int i = 0; i < 2; ++i) { int R, C; stage_rc(tid * 16 + i * 8192, R, C); \
        if constexpr (GATHER) { o0_[i] = (unsigned)(g.arow[(u_).pm * BM + R] * K + C) * 2u; o1_[i] = (unsigned)(g.arow[(u_).pm * BM + HALF + R] * K + C) * 2u; } \
        else { o0_[i] = voffA[i]; o1_[i] = voffA[i] + (unsigned)hstep; } } } while (0)
    PG8_GOFFS(cur, vc0, vc1);
#pragma unroll
    for (int i = 0; i < 2; ++i) { vn0[i] = vc0[i]; vn1[i] = vc1[i]; }
    f32x4 acc[2][2][4][2];
#pragma unroll
    for (int a = 0; a < 2; ++a)
#pragma unroll
        for (int b = 0; b < 2; ++b)
#pragma unroll
            for (int m = 0; m < 4; ++m)
#pragma unroll
                for (int n = 0; n < 2; ++n) acc[a][b][m][n] = (f32x4){0.f, 0.f, 0.f, 0.f};
    bf16x8 At[4][2], B0[2][2], B1[2][2];
    const char* cA = (const char*)(cur.z ? g.A2 : g.A) + (GATHER ? (size_t)0 : (size_t)cur.pm * tstep); const char* cB = (const char*)(cur.z ? g.Bt2 : g.Bt) + (size_t)cur.pn * tstep;
    S.a_ready(cur);
    if constexpr (SP2) {
        PG8_STAGE(PG8_SB(0, 0), cB, voffB); PG8_STAGE(PG8_SB(0, 1), cB + hstep, voffB); PG8_STAGE(PG8_SA(0, 0), cA, vc0); PG8_STAGE(PG8_SA(0, 1), cA, vc1);
        if (wr == 1) PG8_BAR;
        PG8_WAIT_V(2); PG8_BAR;
        PG8_STAGE(PG8_SB(1, 0), cB + kstep, voffB); PG8_STAGE(PG8_SA(1, 0), cA + kstep, vc0); PG8_STAGE(PG8_SB(1, 1), cB + hstep + kstep, voffB);
        PG8_WAIT_V(6); PG8_BAR;
    } else {
        PG8_STAGE(PG8_SB(0, 0), cB, voffB); PG8_STAGE(PG8_SA(0, 0), cA, voffA); PG8_STAGE(PG8_SB(0, 1), cB + hstep, voffB); PG8_STAGE(PG8_SA(0, 1), cA + hstep, voffA);
        if (wr == 1) PG8_BAR;
        PG8_WAIT_V(4); PG8_BAR;
        PG8_STAGE(PG8_SB(1, 0), cB + kstep, voffB); PG8_STAGE(PG8_SA(1, 0), cA + kstep, voffA); PG8_STAGE(PG8_SB(1, 1), cB + hstep + kstep, voffB);
        PG8_WAIT_V(6); PG8_BAR;
    }
    for (;;) {
        const bool has_next = S.next(ui + 1, nxt);
        const char* nA = has_next ? (const char*)(nxt.z ? g.A2 : g.A) + (GATHER ? (size_t)0 : (size_t)nxt.pm * tstep) : cA; const char* nB = has_next ? (const char*)(nxt.z ? g.Bt2 : g.Bt) + (size_t)nxt.pn * tstep : cB;
        if constexpr (GATHER) { if (has_next) PG8_GOFFS(nxt, vn0, vn1); }
        for (int t = 0; t < nt; t += 2) {
            const bool last = (t == nt - 2);
            const char* a1 = cA + (size_t)(t + 1) * kstep;
            const char* a2 = last ? nA : cA + (size_t)(t + 2) * kstep; const char* b2 = last ? nB : cB + (size_t)(t + 2) * kstep;
            const char* a3 = a2 + kstep; const char* b3 = b2 + kstep;
            if (last && has_next) S.a_ready(nxt);
            if constexpr (SP2) {
            PG8_LDB(B0, 0, 0); PG8_LDB(B1, 0, 1); PG8_SCHED; PG8_LDA(At, 0, 0); PG8_STAGE(PG8_SA(1, 1), a1, vc1);
            PG8_WAIT_V(8); PG8_WAIT_L(0); PG8_BAR; PG8_MMA(0, 0, At, B0); PG8_MMA(0, 1, At, B1); PG8_BAR; PG8_SCHED;
            PG8_LDA(At, 0, 1); PG8_STAGE(PG8_SB(0, 0), b2, voffB); PG8_STAGE(PG8_SB(0, 1), b2 + hstep, voffB); { const unsigned vs_[2] = {last ? vn0[0] : vc0[0], last ? vn0[1] : vc0[1]}; PG8_STAGE(PG8_SA(0, 0), a2, vs_); }
            PG8_WAIT_V(8); PG8_WAIT_L(0); PG8_BAR; PG8_MMA(1, 0, At, B0); PG8_MMA(1, 1, At, B1); PG8_BAR; PG8_SCHED;
            PG8_LDB(B0, 1, 0); PG8_LDB(B1, 1, 1); PG8_SCHED; PG8_LDA(At, 1, 0); { const unsigned vs_[2] = {last ? vn1[0] : vc1[0], last ? vn1[1] : vc1[1]}; PG8_STAGE(PG8_SA(0, 1), a2, vs_); }
            PG8_WAIT_V(8); PG8_WAIT_L(0); PG8_BAR; PG8_MMA(0, 0, At, B0); PG8_MMA(0, 1, At, B1); PG8_BAR; PG8_SCHED;
            PG8_LDA(At, 1, 1); PG8_STAGE(PG8_SB(1, 0), b3, voffB); PG8_STAGE(PG8_SB(1, 1), b3 + hstep, voffB); { const unsigned vs_[2] = {last ? vn0[0] : vc0[0], last ? vn0[1] : vc0[1]}; PG8_STAGE(PG8_SA(1, 0), a3, vs_); }
            PG8_WAIT_V(8); PG8_WAIT_L(0); PG8_BAR; PG8_MMA(1, 0, At, B0); PG8_MMA(1, 1, At, B1); PG8_BAR; PG8_SCHED;
            } else {
            PG8_LDB(B0, 0, 0); PG8_SCHED; PG8_LDA(At, 0, 0); PG8_STAGE(PG8_SA(1, 1), a1 + hstep, voffA);
            PG8_WAIT_L(8); PG8_BAR; PG8_WAIT_L(0); PG8_MMA(0, 0, At, B0); PG8_BAR; PG8_SCHED;
            PG8_LDB(B1, 0, 1); PG8_STAGE(PG8_SB(0, 0), b2, voffB);
            PG8_BAR; PG8_WAIT_L(0); PG8_MMA(0, 1, At, B1); PG8_BAR;
            PG8_LDA(At, 0, 1); PG8_STAGE(PG8_SA(0, 0), a2, voffA);
            PG8_BAR; PG8_WAIT_L(0); PG8_MMA(1, 0, At, B0); PG8_BAR; PG8_SCHED;
            PG8_STAGE(PG8_SB(0, 1), b2 + hstep, voffB);
            PG8_WAIT_V(6); PG8_BAR; PG8_MMA(1, 1, At, B1); PG8_BAR;
            PG8_LDB(B0, 1, 0); PG8_SCHED; PG8_LDA(At, 1, 0); PG8_STAGE(PG8_SA(0, 1), a2 + hstep, voffA);
            PG8_WAIT_L(8); PG8_BAR; PG8_WAIT_L(0); PG8_MMA(0, 0, At, B0); PG8_BAR; PG8_SCHED;
            PG8_LDB(B1, 1, 1); PG8_STAGE(PG8_SB(1, 0), b3, voffB);
            PG8_BAR; PG8_WAIT_L(0); PG8_MMA(0, 1, At, B1); PG8_BAR;
            PG8_LDA(At, 1, 1); PG8_STAGE(PG8_SA(1, 0), a3, voffA);
            PG8_BAR; PG8_WAIT_L(0); PG8_MMA(1, 0, At, B0); PG8_BAR; PG8_SCHED;
            PG8_STAGE(PG8_SB(1, 1), b3 + hstep, voffB);
            PG8_WAIT_V(6); PG8_BAR; PG8_MMA(1, 1, At, B1); PG8_BAR;
            }
        }
        if constexpr (ALIGN_EPI) { if (wr == 0) PG8_BAR; }
        if constexpr (!Epi::AFTER_DRAIN) { E(acc, cur, wr, wc, fr, fq); S.done(cur); }
        if (!has_next) break;
#pragma unroll
        for (int a = 0; a < 2; ++a)
#pragma unroll
            for (int b = 0; b < 2; ++b)
#pragma unroll
                for (int m = 0; m < 4; ++m)
#pragma unroll
                    for (int n = 0; n < 2; ++n) acc[a][b][m][n] = (f32x4){0.f, 0.f, 0.f, 0.f};
        cur = nxt; cA = nA; cB = nB; ++ui;
#pragma unroll
        for (int i = 0; i < 2; ++i) { vc0[i] = vn0[i]; vc1[i] = vn1[i]; }
        if constexpr (ALIGN_EPI) { if (wr == 1) PG8_BAR; }
    }
    PG8_WAIT_V(0);
    if constexpr (!ALIGN_EPI) { if (wr == 0) PG8_BAR; }
    PG8_BAR;
    if constexpr (Epi::AFTER_DRAIN) { E.fused(acc, cur, wr, wc, fr, fq, lds, wid, lane); S.done(cur); }
#undef PG8_SA
#undef PG8_SB
#undef PG8_STAGE
#undef PG8_LDA
#undef PG8_LDB
#undef PG8_MMA
#undef PG8_WAIT_V
#undef PG8_WAIT_L
#undef PG8_BAR
#undef PG8_SCHED
#undef PG8_GOFFS
}
}

#define GAS __attribute__((address_space(1)))
#define LAS __attribute__((address_space(3)))
typedef unsigned short bf16;
typedef unsigned v4u __attribute__((ext_vector_type(4)));
typedef unsigned v2u __attribute__((ext_vector_type(2)));
typedef float f32x4 __attribute__((ext_vector_type(4)));
typedef float f32x2 __attribute__((ext_vector_type(2)));
typedef short bf16x8 __attribute__((ext_vector_type(8)));
typedef GAS unsigned gu32;
#define RLX_AGENT __ATOMIC_RELAXED, __HIP_MEMORY_SCOPE_AGENT
#define LDS_WAIT() asm volatile("s_waitcnt lgkmcnt(0)" ::: "memory")
#define VM_WAIT() asm volatile("s_waitcnt vmcnt(0)" ::: "memory")
__device__ __forceinline__ unsigned f2bf(float f) { unsigned u = __builtin_bit_cast(unsigned, f); return (u + 0x7fffu + ((u >> 16) & 1u)) >> 16; }
typedef __bf16 bf16x2_t __attribute__((ext_vector_type(2)));
__device__ __forceinline__ unsigned cvtpk_c(float lo, float hi) { f32x2 v = {lo, hi}; bf16x2_t b2 = __builtin_convertvector(v, bf16x2_t); return __builtin_bit_cast(unsigned, b2); }
__device__ __forceinline__ unsigned pk2(float lo, float hi) { return cvtpk_c(lo, hi); }
__device__ __forceinline__ float bf2f(unsigned v) { return __builtin_bit_cast(float, v << 16); }
__device__ __forceinline__ float bflo(unsigned w) { return __builtin_bit_cast(float, w << 16); }
__device__ __forceinline__ float bfhi(unsigned w) { return __builtin_bit_cast(float, w & 0xffff0000u); }
__device__ __forceinline__ float sigmoidf_(float x) { return __builtin_amdgcn_rcpf(1.f + __expf(-x)); }
__device__ __forceinline__ float siluf_(float x) { return x * __builtin_amdgcn_rcpf(1.f + __expf(-x)); }
__device__ __forceinline__ float wave_sum(float v) {
#pragma unroll
    for (int o = 1; o < 64; o <<= 1) v += __shfl_xor(v, o);
    return v;
}
#define XB_TMO      128
#define XB_XCNT(j)  (256  + 64 * (j))
#define XB_XSUB(j)  (1280 + 64 * (j))
#define XB_XGEN(j)  (2304 + 64 * (j))
#define XB_TOP      3328
#define XB_TOPGEN   3392
#define XCD_BAR_WORDS 3456
#define XB_SPIN_CAP (1u << 18)

__device__ __forceinline__ unsigned xb_ld(unsigned* p)              { return __hip_atomic_load(p, __ATOMIC_RELAXED, __HIP_MEMORY_SCOPE_AGENT); }
__device__ __forceinline__ unsigned xb_add(unsigned* p, unsigned v) { return __hip_atomic_fetch_add(p, v, __ATOMIC_RELAXED, __HIP_MEMORY_SCOPE_AGENT); }
__device__ __forceinline__ unsigned xb_xcc_id() { return (unsigned)__builtin_amdgcn_s_getreg((3 << 11) | 20) & 0xFu; }
#define XB_SPIN(cond, bar) do { unsigned _sp = 0; while (cond) { __builtin_amdgcn_s_sleep(1); \
    if ((++_sp & 255u) == 0u) { if (xb_ld(&(bar)[XB_TMO])) break; if (_sp > XB_SPIN_CAP) { atomicAdd(&(bar)[XB_TMO], 1u); break; } } } } while (0)

struct XcdBarrier {
    unsigned* bar; unsigned x;
    volatile LAS unsigned* st;
};

__device__ __forceinline__ XcdBarrier xcd_barrier_post(unsigned* bar, volatile LAS unsigned* st) {
    XcdBarrier b; b.bar = bar; b.x = xb_xcc_id(); b.st = st;
    if (threadIdx.x == 0) (void)xb_add(&bar[XB_XCNT(b.x)], 1u);
    return b;
}
__device__ __forceinline__ void xcd_barrier_complete(unsigned* bar, unsigned x, unsigned& nloc, unsigned& nx) {
    const unsigned G = gridDim.x * gridDim.y * gridDim.z;
    unsigned sum, cnt, mine, sp = 0u;
    for (;;) {
        sum = 0u; cnt = 0u; mine = 0u;
#pragma unroll
        for (unsigned j = 0; j < 16; ++j) { const unsigned c = xb_ld(&bar[XB_XCNT(j)]); sum += c; cnt += (c > 0u) ? 1u : 0u; mine = (j == x) ? c : mine; }
        if (sum == G) break;
        __builtin_amdgcn_s_sleep(1);
        if ((++sp & 255u) == 0u) { if (xb_ld(&bar[XB_TMO])) break; if (sp > XB_SPIN_CAP) { atomicAdd(&bar[XB_TMO], 1u); break; } }
    }
    nloc = mine > 0u ? mine : 1u; nx = cnt > 0u ? cnt : 1u;
}

__device__ __forceinline__ void xcd_barrier(const XcdBarrier& b) {
    asm volatile("s_waitcnt vmcnt(0)" ::: "memory");
    __syncthreads();
    if (threadIdx.x == 0) {
        unsigned* bar = b.bar;
        __builtin_amdgcn_s_waitcnt(0);
        unsigned nloc = b.st[0], nx = b.st[1];
        if (nloc == 0u) { xcd_barrier_complete(bar, b.x, nloc, nx); b.st[0] = nloc; b.st[1] = nx; }
        const unsigned old = xb_add(&bar[XB_XSUB(b.x)], 1u);
        const unsigned gen = old / nloc;
        if (old + 1u == (gen + 1u) * nloc) {
            __builtin_amdgcn_fence(__ATOMIC_RELEASE, "agent");
            asm volatile("s_waitcnt vmcnt(0)" ::: "memory");
            const unsigned og = xb_add(&bar[XB_TOP], 1u);
            const unsigned tg = og / nx;
            if (og + 1u == (tg + 1u) * nx) xb_add(&bar[XB_TOPGEN], 1u);
            else XB_SPIN(xb_ld(&bar[XB_TOPGEN]) == tg, bar);
            __builtin_amdgcn_fence(__ATOMIC_ACQUIRE, "agent");
            xb_add(&bar[XB_XGEN(b.x)], 1u);
            asm volatile("s_waitcnt vmcnt(0)" ::: "memory");
        } else {
            XB_SPIN(xb_ld(&bar[XB_XGEN(b.x)]) == gen, bar);
            __builtin_amdgcn_fence(__ATOMIC_ACQUIRE, "agent");
            asm volatile("s_waitcnt vmcnt(0)" ::: "memory");
        }
    }
    __syncthreads();
}

constexpr int NB = 4, SEQ = 4096, DM = 1024, NTOK = NB * SEQ;
constexpr int DNH = 8, DHD = 128;
constexpr int MH = 8, QL = 512, KVL = 256, QKD = 192, NOPE = 128;
constexpr int NE = 16, CAP = 512;
constexpr int NPROJ = 7168;
constexpr float EPS = 1e-6f;
constexpr float QSCALE = 0.07216878364870322f * 1.4426950408889634f;
constexpr int NWAVES = 8;

constexpr size_t MiB = 1u << 20;
constexpr size_t WS_CTL = 0, CTL_ZERO_BYTES = 32 * 1024;
constexpr size_t WS_MOD = 1 * MiB;
constexpr size_t WS_IDX = 1 * MiB + 256 * 1024;
constexpr size_t WS_GATEW = 1 * MiB + 512 * 1024;
constexpr size_t WS_ZROW = 1 * MiB + 768 * 1024;
constexpr size_t WS_CS = 2 * MiB;
constexpr size_t WS_BETA = 6 * MiB;
constexpr size_t WS_G = 7 * MiB;
constexpr size_t WS_SSQQ = 8 * MiB;
constexpr size_t WS_SSQKV = 8 * MiB + 512 * 1024;
constexpr size_t WS_KROPE = 9 * MiB;
constexpr size_t WS_GC = 11 * MiB;
constexpr size_t WS_AFF = 12 * MiB;
constexpr size_t WS_SLOT = 13 * MiB;
constexpr size_t WS_WODN = 14 * MiB, WS_WOMLA = 16 * MiB, WS_WOUT = 18 * MiB;
constexpr size_t WS_WIN = 20 * MiB;
constexpr size_t WS_WUQ = 34 * MiB;
constexpr size_t WS_WUKV = 35 * MiB + 512 * 1024;
constexpr size_t WS_ODIR = 20 * MiB;
constexpr size_t WS_A = 37 * MiB;
constexpr size_t WS_QKV = 85 * MiB;
constexpr size_t WS_XE = 85 * MiB, WS_YE = 85 * MiB;
constexpr size_t WS_HID = 149 * MiB;
constexpr size_t WS_Z = 181 * MiB;
constexpr size_t WS_GATES = 213 * MiB;
constexpr size_t WS_WGU = 213 * MiB;
constexpr size_t WS_CQ = 277 * MiB;
constexpr size_t WS_CKV = 293 * MiB;
constexpr size_t WS_OMLA = 277 * MiB;
constexpr size_t WS_WD = 277 * MiB;
constexpr size_t WS_HALO = 309 * MiB;
constexpr size_t WS_CB = 315 * MiB;
constexpr size_t WS_BT = 316 * MiB;
constexpr size_t WS_X1A = 20 * MiB;
constexpr size_t WS_X1B = 69 * MiB;
constexpr size_t WS_END = 317 * MiB;
constexpr int CW_TMO = 0, CW_CODE = 1, CW_BAR = 4096;

constexpr int RING_BYTES = 131072;
constexpr int LDSCTL_OFF = 155648, MISC_OFF = LDSCTL_OFF + 320;
constexpr int LDS_BYTES = 156672;

typedef pg8::Unit Unit;
typedef const f32x4 (&AccRef)[2][2][4][2];
__device__ __forceinline__ v4u pack8(const f32x4 a, const f32x4 b) { v4u w; w.x = pg8::cvt_pk_bf16(a[0], a[1]); w.y = pg8::cvt_pk_bf16(a[2], a[3]); w.z = pg8::cvt_pk_bf16(b[0], b[1]); w.w = pg8::cvt_pk_bf16(b[2], b[3]); return w; }
__device__ __forceinline__ float softplusf_(float x) { return fmaxf(x, 0.f) + log1pf(__expf(-fabsf(x))); }

__device__ __forceinline__ void rope8(f32x4& a, f32x4& b, const float* csrow) {
    const f32x4 c0 = *(const f32x4*)(csrow), c1 = *(const f32x4*)(csrow + 4);
    f32x4 oa, ob;
    oa[0] = a[0] * c0[0] - a[1] * c0[1]; oa[1] = a[1] * c0[0] + a[0] * c0[1];
    oa[2] = a[2] * c0[2] - a[3] * c0[3]; oa[3] = a[3] * c0[2] + a[2] * c0[3];
    ob[0] = b[0] * c1[0] - b[1] * c1[1]; ob[1] = b[1] * c1[0] + b[0] * c1[1];
    ob[2] = b[2] * c1[2] - b[3] * c1[3]; ob[3] = b[3] * c1[2] + b[2] * c1[3];
    a = oa; b = ob;
}

struct EpiProj {
    static constexpr bool PERM = true, AFTER_DRAIN = false;
    bf16 *qkv, *z, *gates, *cq, *ckv, *halo, *krope; float *ssq_q, *ssq_kv, *beta, *g; const float *cs, *a_log, *dt_bias;
    __device__ __forceinline__ void operator()(AccRef acc, const Unit& u, int wr, int wc, int fr, int fq) const {
        const int pn = u.pn, rbase = u.pm * 256 + wr * 64 + fr, cin = wc * 32 + 8 * fq;
        if (pn < 12) {
#pragma unroll
            for (int ai = 0; ai < 2; ++ai)
#pragma unroll
                for (int m = 0; m < 4; ++m) { const int row = rbase + ai * 128 + m * 16, t64 = row & 63;
                    const bool hl = (t64 < 2) || (t64 >= 62); const int hidx = (row >> 6) * 4 + (t64 < 2 ? t64 : t64 - 60);
#pragma unroll
                    for (int bj = 0; bj < 2; ++bj) { const int col = pn * 256 + bj * 128 + cin; const v4u w = pack8(acc[ai][bj][m][0], acc[ai][bj][m][1]);
                        *(v4u*)(qkv + (size_t)row * 3072 + col) = w; if (hl) *(v4u*)(halo + (size_t)hidx * 3072 + col) = w; } }
        } else if (pn < 16) {
#pragma unroll
            for (int ai = 0; ai < 2; ++ai)
#pragma unroll
                for (int m = 0; m < 4; ++m) { const int row = rbase + ai * 128 + m * 16;
#pragma unroll
                    for (int bj = 0; bj < 2; ++bj) { const int col = (pn - 12) * 256 + bj * 128 + cin; *(v4u*)(z + (size_t)row * 1024 + col) = pack8(acc[ai][bj][m][0], acc[ai][bj][m][1]); } }
        } else if (pn < 24) {
#pragma unroll
            for (int ai = 0; ai < 2; ++ai)
#pragma unroll
                for (int m = 0; m < 4; ++m) { const int row = rbase + ai * 128 + m * 16;
#pragma unroll
                    for (int bj = 0; bj < 2; ++bj) { const int col = (pn - 16) * 256 + bj * 128 + cin; f32x4 a = acc[ai][bj][m][0], b = acc[ai][bj][m][1];
#pragma unroll
                        for (int e = 0; e < 4; ++e) { a[e] = sigmoidf_(a[e]); b[e] = sigmoidf_(b[e]); }
                        *(v4u*)(gates + (size_t)row * 2048 + col) = pack8(a, b); } }
        } else if (pn < 27) {
            const bool isq = pn < 26; bf16* dst = isq ? cq : ckv; const int pitch = isq ? 512 : 256, cb = isq ? (pn - 24) * 256 : 0;
#pragma unroll
            for (int ai = 0; ai < 2; ++ai)
#pragma unroll
                for (int m = 0; m < 4; ++m) { const int row = rbase + ai * 128 + m * 16; float s = 0.f;
#pragma unroll
                    for (int bj = 0; bj < 2; ++bj) { const f32x4 a = acc[ai][bj][m][0], b = acc[ai][bj][m][1];
                        s += (a[0] * a[0] + a[1] * a[1]) + (a[2] * a[2] + a[3] * a[3]) + (b[0] * b[0] + b[1] * b[1]) + (b[2] * b[2] + b[3] * b[3]);
                        *(v4u*)(dst + (size_t)row * pitch + cb + bj * 128 + cin) = pack8(a, b); }
                    s += __shfl_xor(s, 16); s += __shfl_xor(s, 32);
                    if (fq == 0) { if (isq) ssq_q[row * 8 + (pn - 24) * 4 + wc] = s; else ssq_kv[row * 4 + wc] = s; } }
        } else {
#pragma unroll
            for (int ai = 0; ai < 2; ++ai)
#pragma unroll
                for (int m = 0; m < 4; ++m) { const int row = rbase + ai * 128 + m * 16; f32x4 a = acc[ai][0][m][0], b = acc[ai][0][m][1];
                    if (wc < 2) { rope8(a, b, cs + ((size_t)row * 32 + cin / 2) * 2); *(v4u*)(krope + (size_t)row * 64 + cin) = pack8(a, b); }
                    else if (wc == 2) {
                        if (fq < 2) { f32x4 oa, ob;
#pragma unroll
                            for (int e = 0; e < 4; ++e) { oa[e] = sigmoidf_(a[e]); ob[e] = sigmoidf_(b[e]); }
                            *(f32x4*)(beta + (size_t)row * 16 + 8 * fq) = oa; *(f32x4*)(beta + (size_t)row * 16 + 8 * fq + 4) = ob; }
                        else { const int j0 = 8 * (fq - 2); f32x4 oa, ob;
#pragma unroll
                            for (int e = 0; e < 4; ++e) { oa[e] = -__expf(a_log[j0 + e]) * softplusf_(a[e] + dt_bias[j0 + e]); ob[e] = -__expf(a_log[j0 + 4 + e]) * softplusf_(b[e] + dt_bias[j0 + 4 + e]); }
                            *(f32x4*)(g + (size_t)row * 16 + j0) = oa; *(f32x4*)(g + (size_t)row * 16 + j0 + 4) = ob; } } }
        }
    }
};

struct EpiQ {
    static constexpr bool PERM = true, AFTER_DRAIN = false;
    bf16* q; const float *ssq, *cs;
    __device__ __forceinline__ void operator()(AccRef acc, const Unit& u, int wr, int wc, int fr, int fq) const {
        const int rbase = u.pm * 256 + wr * 64 + fr, cin = wc * 32 + 8 * fq;
#pragma unroll
        for (int ai = 0; ai < 2; ++ai)
#pragma unroll
            for (int m = 0; m < 4; ++m) { const int row = rbase + ai * 128 + m * 16;
                const f32x4 s0 = *(const f32x4*)(ssq + (size_t)row * 8), s1 = *(const f32x4*)(ssq + (size_t)row * 8 + 4);
                const float r = rsqrtf(((s0[0] + s0[1]) + (s0[2] + s0[3]) + (s1[0] + s1[1]) + (s1[2] + s1[3])) * (1.f / QL) + EPS) * QSCALE;
#pragma unroll
                for (int bj = 0; bj < 2; ++bj) { const int col = u.pn * 256 + bj * 128 + cin, off = col % QKD; f32x4 a = acc[ai][bj][m][0] * r, b = acc[ai][bj][m][1] * r;
                    if (off >= NOPE) rope8(a, b, cs + ((size_t)row * 32 + (off - NOPE) / 2) * 2);
                    *(v4u*)(q + (size_t)row * 1536 + col) = pack8(a, b); } }
    }
};
struct EpiKV {
    static constexpr bool PERM = true, AFTER_DRAIN = false;
    bf16* kv; const float* ssq;
    __device__ __forceinline__ void operator()(AccRef acc, const Unit& u, int wr, int wc, int fr, int fq) const {
        const int rbase = u.pm * 256 + wr * 64 + fr, cin = wc * 32 + 8 * fq;
#pragma unroll
        for (int ai = 0; ai < 2; ++ai)
#pragma unroll
            for (int m = 0; m < 4; ++m) { const int row = rbase + ai * 128 + m * 16;
                const f32x4 s0 = *(const f32x4*)(ssq + (size_t)row * 4);
                const float r = rsqrtf(((s0[0] + s0[1]) + (s0[2] + s0[3])) * (1.f / KVL) + EPS);
#pragma unroll
                for (int bj = 0; bj < 2; ++bj) { const int col = u.pn * 256 + bj * 128 + cin;
                    *(v4u*)(kv + (size_t)row * 2048 + col) = pack8(acc[ai][bj][m][0] * r, acc[ai][bj][m][1] * r); } }
    }
};
__device__ __forceinline__ void unpack8(const v4u w, f32x4& a, f32x4& b) { a[0] = bflo(w.x); a[1] = bfhi(w.x); a[2] = bflo(w.y); a[3] = bfhi(w.y); b[0] = bflo(w.z); b[1] = bfhi(w.z); b[2] = bflo(w.w); b[3] = bfhi(w.w); }
template <int MODE>
struct EpiMix {
    static constexpr bool PERM = true, AFTER_DRAIN = false;
    bf16* y; const bf16* gates;
    __device__ __forceinline__ void operator()(AccRef acc, const Unit& u, int wr, int wc, int fr, int fq) const {
        const int rbase = u.pm * 256 + wr * 64 + fr, cin = wc * 32 + 8 * fq;
#pragma unroll
        for (int bj = 0; bj < 2; ++bj) { const int col = u.pn * 256 + bj * 128 + cin;
#pragma unroll
            for (int ai = 0; ai < 2; ++ai) { v4u gv[4], yv[4];
#pragma unroll
                for (int m = 0; m < 4; ++m) { const int row = rbase + ai * 128 + m * 16; gv[m] = *(const v4u*)(gates + (size_t)row * 2048 + MODE * 1024 + col);
                    if (MODE == 1) yv[m] = *(const v4u*)(y + (size_t)row * 1024 + col); }
                asm volatile("" ::: "memory");
#pragma unroll
                for (int m = 0; m < 4; ++m) { const int row = rbase + ai * 128 + m * 16;
                    f32x4 ga, gb; unpack8(gv[m], ga, gb);
                    f32x4 a = acc[ai][bj][m][0] * ga, b = acc[ai][bj][m][1] * gb;
                    if (MODE == 1) { f32x4 ya, yb; unpack8(yv[m], ya, yb); a = a + ya; b = b + yb; }
                    *(v4u*)(y + (size_t)row * 1024 + col) = pack8(a, b); }
                asm volatile("" ::: "memory"); }
        }
    }
};
struct EpiOut {
    static constexpr bool PERM = true, AFTER_DRAIN = false;
    unsigned char* ws; const float *x, *mod;
    __device__ __forceinline__ void operator()(AccRef acc, const Unit& u, int wr, int wc, int fr, int fq) const {
        const int rbase = u.pm * 256 + wr * 64 + fr, cin = wc * 32 + 8 * fq; const int b = (u.pm * 256) / SEQ;
        bf16* x1 = (u.pm < 32) ? (bf16*)(ws + WS_X1A) : (bf16*)(ws + WS_X1B) - (size_t)8192 * 1024;
#pragma unroll
        for (int bj = 0; bj < 2; ++bj) { const int col = u.pn * 256 + bj * 128 + cin;
            const f32x4 g0 = *(const f32x4*)(mod + b * 6144 + 2048 + col), g1 = *(const f32x4*)(mod + b * 6144 + 2048 + col + 4);
#pragma unroll
            for (int ai = 0; ai < 2; ++ai) { f32x4 xv[4][2];
#pragma unroll
                for (int m = 0; m < 4; ++m) { const size_t o = (size_t)(rbase + ai * 128 + m * 16) * 1024 + col; xv[m][0] = *(const f32x4*)(x + o); xv[m][1] = *(const f32x4*)(x + o + 4); }
                asm volatile("" ::: "memory");
#pragma unroll
                for (int m = 0; m < 4; ++m) { const size_t o = (size_t)(rbase + ai * 128 + m * 16) * 1024 + col;
                    *(v4u*)(x1 + o) = pack8(xv[m][0] + g0 * acc[ai][bj][m][0], xv[m][1] + g1 * acc[ai][bj][m][1]); }
                asm volatile("" ::: "memory"); } }
    }
};
struct EpiGU {
    static constexpr bool PERM = true, AFTER_DRAIN = false;
    bf16* hid;
    __device__ __forceinline__ void operator()(AccRef acc, const Unit& u, int wr, int wc, int fr, int fq) const {
        const int rbase = u.pm * 256 + wr * 64 + fr, cin = wc * 32 + 8 * fq;
#pragma unroll
        for (int ai = 0; ai < 2; ++ai)
#pragma unroll
            for (int m = 0; m < 4; ++m) { const int row = rbase + ai * 128 + m * 16;
#pragma unroll
                for (int bj = 0; bj < 2; ++bj) { const int hc = ((u.pn & 7) * 256 + bj * 128 + cin) >> 1; const f32x4 gt = acc[ai][bj][m][0], up = acc[ai][bj][m][1];
                    v2u w; w.x = pg8::cvt_pk_bf16(siluf_(gt[0]) * up[0], siluf_(gt[1]) * up[1]); w.y = pg8::cvt_pk_bf16(siluf_(gt[2]) * up[2], siluf_(gt[3]) * up[3]);
                    *(v2u*)(hid + (size_t)row * 1024 + hc) = w; } }
    }
};
struct EpiDown {
    static constexpr bool PERM = true, AFTER_DRAIN = false;
    bf16* ye; const float* gatew;
    __device__ __forceinline__ void operator()(AccRef acc, const Unit& u, int wr, int wc, int fr, int fq) const {
        const int rbase = u.pm * 256 + wr * 64 + fr, cin = wc * 32 + 8 * fq;
        float gws[2][4];
#pragma unroll
        for (int ai = 0; ai < 2; ++ai)
#pragma unroll
            for (int m = 0; m < 4; ++m) gws[ai][m] = gatew[rbase + ai * 128 + m * 16];
        asm volatile("" ::: "memory");
#pragma unroll
        for (int ai = 0; ai < 2; ++ai)
#pragma unroll
            for (int m = 0; m < 4; ++m) { const int row = rbase + ai * 128 + m * 16; const float gw = gws[ai][m];
#pragma unroll
                for (int bj = 0; bj < 2; ++bj) { const int col = (u.pn & 3) * 256 + bj * 128 + cin;
                    *(v4u*)(ye + (size_t)row * 1024 + col) = pack8(acc[ai][bj][m][0] * gw, acc[ai][bj][m][1] * gw); } }
    }
};
struct MoeOrder {
    int nwg, G, c, ntn, reps;
    __device__ void init(int ntn_, int G_, int c_, int reps_ = 1) { ntn = ntn_; nwg = 64 * 2 * ntn_; G = G_; c = c_; reps = reps_; }
    __device__ bool next(int i, Unit& u) const { if (reps > 1) { const int per = (nwg - c + G - 1) / G; if (i >= per * reps) return false; i %= per; }
        const int L = i * G + c; if (L >= nwg) return false;
        int nt, mh, be;
        if (G == 256) {
            const int x = c & 7, j = c >> 3, per_round = 128 / ntn;
            nt = j % ntn; mh = (j / ntn) & 1; be = i * per_round + (j / (2 * ntn)) * 8 + x;
        } else { nt = L % ntn; mh = (L / ntn) & 1; be = L / (2 * ntn); }
        u.pm = be * 2 + mh; u.pn = (be & 15) * ntn + nt; u.z = 0; return true; }
    __device__ __forceinline__ void a_ready(const Unit&) const {}
    __device__ __forceinline__ void done(const Unit&) const {}
};

struct KvOrder {
    int G, c, reps;
    __device__ void init(int G_, int c_, int reps_ = 1) { G = G_; c = c_; reps = reps_; }
    __device__ bool next(int i, Unit& u) const { int L;
        if (G == 256) { const int per = (c < 128) ? 1 : 3; if (i >= per * reps) return false; i %= per; L = (c < 128) ? c : 128 + (c - 128) * 3 + i; }
        else { const int per = (512 - c + G - 1) / G; if (i >= per * reps) return false; i %= per; L = i * G + c; }
        u.pm = L >> 3; u.pn = L & 7; u.z = 0; return true; }
    __device__ __forceinline__ void a_ready(const Unit&) const {}
    __device__ __forceinline__ void done(const Unit&) const {}
};

struct EpiMixZ {
    static constexpr bool PERM = true, AFTER_DRAIN = false;
    bf16* y; const bf16* gates;
    __device__ __forceinline__ void operator()(AccRef acc, const Unit& u, int wr, int wc, int fr, int fq) const {
        if (u.z == 0) { EpiMix<0> E{y, gates}; E(acc, u, wr, wc, fr, fq); } else { EpiMix<1> E{y, gates}; E(acc, u, wr, wc, fr, fq); }
    }
};
struct PairOrder {
    pg8::StaticOrder S; int reps;
    __device__ void init(int M, int N, int G_, int c_, int reps_ = 1) { S.init(M, N, G_, c_); reps = reps_; }
    __device__ bool next(int i, Unit& u) const { const int per = (S.nwg - S.c + S.G - 1) / S.G; if (i >= 2 * per * reps) return false; i %= 2 * per; const bool ok = S.next(i >> 1, u); u.z = i & 1; return ok; }
    __device__ __forceinline__ void a_ready(const Unit&) const {}
    __device__ __forceinline__ void done(const Unit&) const {}
};

namespace att {
using bf16x8 = __attribute__((ext_vector_type(8))) short;
using s16x4  = __attribute__((ext_vector_type(4))) short;
using f32x16 = __attribute__((ext_vector_type(16))) float;
using u32x4  = __attribute__((ext_vector_type(4))) unsigned;
constexpr int KVBLK = 64;
constexpr int SHM_V = 16384, SHM_KN = 16384, SHM_KR = 8192;
constexpr int OFF_V = 0, OFF_KN = 2 * SHM_V, OFF_KR = OFF_KN + 2 * SHM_KN, OFF_WS = OFF_KR + 2 * SHM_KR, OFF_QR = OFF_WS + 8 * 64 * 4, ATT_LDS = OFF_QR + 8 * 4096;
constexpr float THR2 = 8.f * 1.4426950408889634f;
#define KSWZ(row, colB) ((row) * 256 + ((colB) ^ (((row) & 7) << 4)))
#define KRSWZ(row, colB) ((row) * 128 + ((colB) ^ ((((row) >> 1) & 7) << 4)))
#define SBAR() __builtin_amdgcn_sched_barrier(0)
__device__ __forceinline__ int crow(int r, int hi) { return (r & 3) + 8 * (r >> 2) + 4 * hi; }
__device__ __forceinline__ unsigned cvtpk(float lo, float hi) { return cvtpk_c(lo, hi); }
__device__ __forceinline__ void partialSM(f32x16& p0, f32x16& p1, float& m_reg, float& mn, float& alpha) {
  float pmax = p0[0];
#pragma unroll
  for (int r = 1; r < 16; ++r) pmax = fmaxf(pmax, p0[r]);
#pragma unroll
  for (int r = 0; r < 16; ++r) pmax = fmaxf(pmax, p1[r]);
  { auto rr = __builtin_amdgcn_permlane32_swap(__float_as_uint(pmax), __float_as_uint(pmax), false, false);
    pmax = fmaxf(__uint_as_float(rr[0]), __uint_as_float(rr[1])); }
  if (__builtin_expect(__all(pmax - m_reg <= THR2), 1)) { mn = m_reg; alpha = 1.f; }
  else { mn = fmaxf(m_reg, pmax); alpha = __builtin_amdgcn_exp2f(m_reg - mn); m_reg = mn; }
#pragma unroll
  for (int r = 0; r < 16; ++r) p0[r] = p0[r] - mn;
#pragma unroll
  for (int r = 0; r < 16; ++r) p1[r] = p1[r] - mn;
#pragma unroll
  for (int r = 0; r < 16; ++r) p0[r] = __builtin_amdgcn_exp2f(p0[r]);
}
__device__ __forceinline__ void finishSM(f32x16& p0, f32x16& p1, float alpha, float& l_reg, bf16x8& pa0, bf16x8& pa1, bf16x8& pa2, bf16x8& pa3) {
#pragma unroll
  for (int r = 0; r < 16; ++r) p1[r] = __builtin_amdgcn_exp2f(p1[r]);
  float ps = 0;
#pragma unroll
  for (int r = 0; r < 16; ++r) ps += p0[r];
#pragma unroll
  for (int r = 0; r < 16; ++r) ps += p1[r];
  { auto rr = __builtin_amdgcn_permlane32_swap(__float_as_uint(ps), __float_as_uint(ps), false, false);
    ps = __uint_as_float(rr[0]) + __uint_as_float(rr[1]); }
  l_reg = l_reg * alpha + ps;
#define PK4(P, BASE, OUT) do { unsigned a0 = cvtpk(P[BASE + 0], P[BASE + 1]), a1 = cvtpk(P[BASE + 2], P[BASE + 3]);   \
    unsigned b0 = cvtpk(P[BASE + 4], P[BASE + 5]), b1 = cvtpk(P[BASE + 6], P[BASE + 7]);                              \
    auto r0 = __builtin_amdgcn_permlane32_swap(a0, b0, false, false); auto r1 = __builtin_amdgcn_permlane32_swap(a1, b1, false, false); \
    u32x4 w = {r0[0], r1[0], r0[1], r1[1]}; OUT = __builtin_bit_cast(bf16x8, w); } while (0)
  PK4(p0, 0, pa0); PK4(p0, 8, pa1); PK4(p1, 0, pa2); PK4(p1, 8, pa3);
#undef PK4
}
__device__ __forceinline__ void qkt(f32x16& p0, f32x16& p1, const char* Kn, const char* Kr, const bf16x8* qr, const char* qrl, int r32, int hi) {
  p0 = f32x16{}; p1 = f32x16{};
#pragma unroll
  for (int d0 = 0; d0 < 8; ++d0) { const int cb = (d0 * 16 + hi * 8) * 2;
    bf16x8 b0 = *reinterpret_cast<const bf16x8*>(Kn + KSWZ(r32, cb));
    bf16x8 b1 = *reinterpret_cast<const bf16x8*>(Kn + KSWZ(32 + r32, cb));
    p0 = __builtin_amdgcn_mfma_f32_32x32x16_bf16(b0, qr[d0], p0, 0, 0, 0);
    p1 = __builtin_amdgcn_mfma_f32_32x32x16_bf16(b1, qr[d0], p1, 0, 0, 0); }
#pragma unroll
  for (int d0 = 0; d0 < 4; ++d0) { const int cb = (d0 * 16 + hi * 8) * 2;
    bf16x8 b0 = *reinterpret_cast<const bf16x8*>(Kr + KRSWZ(r32, cb));
    bf16x8 b1 = *reinterpret_cast<const bf16x8*>(Kr + KRSWZ(32 + r32, cb));
    const bf16x8 qf = *reinterpret_cast<const bf16x8*>(qrl + d0 * 1024);
    p0 = __builtin_amdgcn_mfma_f32_32x32x16_bf16(b0, qf, p0, 0, 0, 0);
    p1 = __builtin_amdgcn_mfma_f32_32x32x16_bf16(b1, qf, p1, 0, 0, 0); }
}
__device__ __forceinline__ int v_st(int k, int c) { const int kk = (k & ~0xC) | ((k & 4) << 1) | ((k & 8) >> 1); return ((kk >> 3) * 4 + (c >> 5)) * 512 + ((kk & 7) * 32 + (c & 31)) * 2; }
__device__ __forceinline__ int v_rd_base(int lane) { return ((lane & 3) << 3) | (((lane >> 2) & 3) << 6) | (((lane >> 4) & 1) << 5) | (((lane >> 5) & 1) << 8); }
constexpr int v_rd_off(int d0, int ks, int half) { return d0 * 512 + ks * 4096 + half * 2048; }
template <int OFF> __device__ __forceinline__ s16x4 tr_read(int vb) {
  s16x4 r; asm volatile("ds_read_b64_tr_b16 %0, %1 offset:%2" : "=&v"(r) : "v"(vb), "i"(OFF) : "memory"); return r;
}
template <int D0> __device__ __forceinline__ void pv_one(f32x16& od, int vb, bf16x8 pa0, bf16x8 pa1, bf16x8 pa2, bf16x8 pa3) {
  const s16x4 l0 = tr_read<v_rd_off(D0, 0, 0)>(vb), h0 = tr_read<v_rd_off(D0, 0, 1)>(vb), l1 = tr_read<v_rd_off(D0, 1, 0)>(vb), h1 = tr_read<v_rd_off(D0, 1, 1)>(vb);
  const s16x4 l2 = tr_read<v_rd_off(D0, 2, 0)>(vb), h2 = tr_read<v_rd_off(D0, 2, 1)>(vb), l3 = tr_read<v_rd_off(D0, 3, 0)>(vb), h3 = tr_read<v_rd_off(D0, 3, 1)>(vb);
  asm volatile("s_waitcnt lgkmcnt(0)" ::: "memory"); SBAR();
#define PK(L, H) (bf16x8){L[0], L[1], L[2], L[3], H[0], H[1], H[2], H[3]}
  od = __builtin_amdgcn_mfma_f32_32x32x16_bf16(pa0, PK(l0, h0), od, 0, 0, 0);
  od = __builtin_amdgcn_mfma_f32_32x32x16_bf16(pa1, PK(l1, h1), od, 0, 0, 0);
  od = __builtin_amdgcn_mfma_f32_32x32x16_bf16(pa2, PK(l2, h2), od, 0, 0, 0);
  od = __builtin_amdgcn_mfma_f32_32x32x16_bf16(pa3, PK(l3, h3), od, 0, 0, 0);
#undef PK
}
__device__ __forceinline__ void pv_d0(f32x16* o, int vb, bf16x8 pa0, bf16x8 pa1, bf16x8 pa2, bf16x8 pa3) {
  pv_one<0>(o[0], vb, pa0, pa1, pa2, pa3); pv_one<1>(o[1], vb, pa0, pa1, pa2, pa3); pv_one<2>(o[2], vb, pa0, pa1, pa2, pa3); pv_one<3>(o[3], vb, pa0, pa1, pa2, pa3);
}
__device__ __forceinline__ void attn_unit(const unsigned short* __restrict__ Qb, const unsigned short* __restrict__ Kn, const unsigned short* __restrict__ Vh, const unsigned short* __restrict__ Kr,
                                          unsigned short* __restrict__ Ob, int seq, char* lds, bool dry = false) {
#ifndef PROBE_VARIANT
#define PROBE_VARIANT 0
#endif
#define PVA(bit) (dry && ((PROBE_VARIANT >> (bit)) & 1))
  const int tid = threadIdx.x, wid = tid >> 6, lane = tid & 63, r32 = lane & 31, hi = lane >> 5;
  char* V_lds = lds + OFF_V; char* KN_lds = lds + OFF_KN; char* KR_lds = lds + OFF_KR;
  float* ws = (float*)(lds + OFF_WS) + wid * 64; float* li_l = ws; float* al_l = ws + 32;
  float m_reg = -1e30f, l_reg = 0; f32x16 o[4] = {}; bf16x8 qr[8];
  const unsigned short* Qw = Qb + (long)(wid * 32 + r32) * 1536 + hi * 8;
  char* qrl = lds + OFF_QR + wid * 4096 + lane * 16;
#pragma unroll
  for (int d0 = 0; d0 < 8; ++d0) qr[d0] = *reinterpret_cast<const bf16x8*>(Qw + d0 * 16);
#pragma unroll
  for (int d0 = 0; d0 < 4; ++d0) *reinterpret_cast<bf16x8*>(qrl + d0 * 1024) = *reinterpret_cast<const bf16x8*>(Qw + (8 + d0) * 16);
  const int sr = tid >> 4, sc = (tid & 15) * 8, vst0 = v_st(sr, sc), vst1 = v_st(32 + sr, sc);
  const int rr_ = tid >> 3, rc_ = (tid & 7) * 8;
  const int vb0 = (int)(uintptr_t)V_lds + v_rd_base(lane);
  bf16x8 vs0, vs1, ks0, ks1, kr0;
  const unsigned kvoff = (unsigned)(sr * 2048 + sc) * 2u, kroff = (unsigned)(rr_ * 64 + rc_) * 2u;
#define SLOAD(k0) do { const char* kb_ = (const char*)Kn + (size_t)(k0) * 4096; const char* vb_ = (const char*)Vh + (size_t)(k0) * 4096; const char* rb_ = (const char*)Kr + (size_t)(k0) * 128; \
    vs0 = *reinterpret_cast<const bf16x8*>(vb_ + kvoff); vs1 = *reinterpret_cast<const bf16x8*>(vb_ + 131072 + kvoff); \
    ks0 = *reinterpret_cast<const bf16x8*>(kb_ + kvoff); ks1 = *reinterpret_cast<const bf16x8*>(kb_ + 131072 + kvoff); \
    kr0 = *reinterpret_cast<const bf16x8*>(rb_ + kroff); } while (0)
#define SWRITE(b) do { *(bf16x8*)(V_lds + (b) * SHM_V + vst0) = vs0; *(bf16x8*)(V_lds + (b) * SHM_V + vst1) = vs1; const int kc = sc * 2; \
    *(bf16x8*)(KN_lds + (b) * SHM_KN + KSWZ(sr, kc)) = ks0; *(bf16x8*)(KN_lds + (b) * SHM_KN + KSWZ(32 + sr, kc)) = ks1; \
    *(bf16x8*)(KR_lds + (b) * SHM_KR + KRSWZ(rr_, rc_ * 2)) = kr0; } while (0)
#define SWAIT() asm volatile("s_waitcnt vmcnt(0)" ::: "memory")
#define RESC(a) do { if (__any((a) < 1.f)) { if (hi == 0) al_l[r32] = (a); asm volatile("s_waitcnt lgkmcnt(0)" ::: "memory"); \
    _Pragma("unroll") for (int d = 0; d < 4; ++d) _Pragma("unroll") for (int r = 0; r < 16; ++r) o[d][r] *= al_l[crow(r, hi)]; } } while (0)
  f32x16 pA0, pA1, pB0, pB1; float mnA, mnB, alA, alB; bf16x8 pa0, pa1, pa2, pa3; const int NT = seq / KVBLK;
  SLOAD(0); SWAIT(); SWRITE(0); __syncthreads();
  qkt(pA0, pA1, KN_lds, KR_lds, qr, qrl, r32, hi); partialSM(pA0, pA1, m_reg, mnA, alA);
  SLOAD(KVBLK); SWAIT(); SWRITE(1); __syncthreads();
  for (int j = 1; j + 1 < NT; j += 2) {
    SBAR(); qkt(pB0, pB1, KN_lds + SHM_KN, KR_lds + SHM_KR, qr, qrl, r32, hi);
    if (!PVA(13)) finishSM(pA0, pA1, alA, l_reg, pa0, pa1, pa2, pa3); SBAR();
    if (!PVA(12)) SLOAD((j + 1) * KVBLK); SBAR();
    pv_d0(o, vb0, pa0, pa1, pa2, pa3); if (!PVA(13)) partialSM(pB0, pB1, m_reg, mnB, alB);
    if (!PVA(14)) __syncthreads(); if (!PVA(12)) { SWAIT(); SWRITE(0); }
    RESC(alB); if (!PVA(14)) __syncthreads();
    SBAR(); qkt(pA0, pA1, KN_lds, KR_lds, qr, qrl, r32, hi);
    if (!PVA(13)) finishSM(pB0, pB1, alB, l_reg, pa0, pa1, pa2, pa3); SBAR();
    if (!PVA(12)) SLOAD((j + 2) * KVBLK); SBAR();
    pv_d0(o, vb0 + SHM_V, pa0, pa1, pa2, pa3); if (!PVA(13)) partialSM(pA0, pA1, m_reg, mnA, alA);
    if (!PVA(14)) __syncthreads(); if (!PVA(12)) { SWAIT(); SWRITE(1); }
    RESC(alA); if (!PVA(14)) __syncthreads();
  }
  SBAR(); qkt(pB0, pB1, KN_lds + SHM_KN, KR_lds + SHM_KR, qr, qrl, r32, hi);
  finishSM(pA0, pA1, alA, l_reg, pa0, pa1, pa2, pa3); SBAR();
  pv_d0(o, vb0, pa0, pa1, pa2, pa3); partialSM(pB0, pB1, m_reg, mnB, alB);
  __syncthreads(); RESC(alB);
  finishSM(pB0, pB1, alB, l_reg, pa0, pa1, pa2, pa3); SBAR();
  pv_d0(o, vb0 + SHM_V, pa0, pa1, pa2, pa3);
  if (hi == 0) li_l[r32] = l_reg; asm volatile("s_waitcnt lgkmcnt(0)" ::: "memory");
  float rli[16];
#pragma unroll
  for (int r = 0; r < 16; ++r) rli[r] = __builtin_amdgcn_rcpf(li_l[crow(r, hi)]);
  __syncthreads();
  { char* ost = lds + OFF_V + wid * 8192;
    unsigned obase = (unsigned)(uintptr_t)ost + hi * 1024 + r32 * 2; asm volatile("" : "+v"(obase));
#pragma unroll
    for (int r = 0; r < 16; ++r) {
#pragma unroll
      for (int d0 = 0; d0 < 4; ++d0) *(__attribute__((address_space(3))) unsigned short*)(uintptr_t)(obase + crow(r, 0) * 256 + d0 * 64) = (unsigned short)f2bf(o[d0][r] * rli[r]); }
    asm volatile("s_waitcnt lgkmcnt(0)" ::: "memory");
    unsigned short* Ow = Ob + (long)(wid * 32) * 1024;
    if (!dry) {
      const unsigned gvo = (unsigned)(lane >> 4) * 2048u + (unsigned)(lane & 15) * 16u;
#pragma unroll
      for (int q = 0; q < 8; ++q) *(u32x4*)((char*)Ow + (size_t)q * 8192 + gvo) = *(const u32x4*)(ost + (q * 64 + lane) * 16); } }
  __syncthreads();
#undef SLOAD
#undef SWRITE
#undef SWAIT
#undef RESC
}
#undef KSWZ
#undef KRSWZ
#undef SBAR
}

struct Ctx {
    LAS unsigned char* lds; unsigned char* ws; float* out;
    int tid, lane, wave, G, bid, gw, NGW;
    const float *x, *c, *w_mod, *b_mod, *g_mix, *w_in, *conv_w, *a_log, *dt_bias, *dn_o_gain, *q_gain, *w_uq, *kv_gain, *w_ukv, *w_o_dn, *w_o_mla, *w_out, *g_ffn, *w_router, *w_gate, *w_up, *w_down, *g_final;
    const int* positions;
};

template <class RowMap>
__device__ __forceinline__ void transpose_item(const float* W, int K, int N, bf16* WT, const float* kscale, LAS float* scr, int item, int lane, RowMap rm) {
    const int nblk = N / 32, kb = item / nblk, nb = item % nblk, k0 = 64 * kb, n0 = 32 * nb;
    { float tv[32];
#pragma unroll
      for (int i = 0; i < 32; ++i) { const int kk = 2 * i + (lane >> 5); tv[i] = W[(size_t)(k0 + kk) * N + n0 + (lane & 31)]; }
#pragma unroll
      for (int i = 0; i < 32; ++i) { const int kk = 2 * i + (lane >> 5); float v = tv[i]; if (kscale) v *= kscale[k0 + kk]; scr[kk * 33 + (lane & 31)] = v; } }
    LDS_WAIT(); asm volatile("" ::: "memory");
    const int c = lane & 7;
#pragma unroll
    for (int j = 0; j < 4; ++j) { const int n = (lane >> 3) + 8 * j; const LAS float* s = scr + (8 * c) * 33 + n;
        v4u o; o.x = pk2(s[0 * 33], s[1 * 33]); o.y = pk2(s[2 * 33], s[3 * 33]); o.z = pk2(s[4 * 33], s[5 * 33]); o.w = pk2(s[6 * 33], s[7 * 33]);
        *(GAS v4u*)(WT + (size_t)rm(n0 + n) * K + k0 + 8 * c) = o; }
    LDS_WAIT(); asm volatile("" ::: "memory");
}
__device__ __forceinline__ int win_dest_row(int s) {
    if (s < 4096) return s;
    if (s < 4112) return 6912 + 64 + (s - 4096);
    if (s < 4128) return 6912 + 80 + (s - 4112);
    if (s < 4640) return 6144 + (s - 4128);
    if (s < 4896) return 6656 + (s - 4640);
    if (s < 4960) { const int i = s - 4896; return 6912 + (i < 32 ? 2 * i : 2 * (i - 32) + 1); }
    return 4096 + (s - 4960);
}
__device__ __forceinline__ int wuq_dest_row(int s) { const int h = s / QKD, o = s % QKD; if (o < NOPE) return s; const int i = o - NOPE; return h * QKD + NOPE + (i < 32 ? 2 * i : 2 * (i - 32) + 1); }

__device__ __forceinline__ void p0_prologue(const Ctx& C0) {
    Ctx C = C0; asm volatile("" : "+v"(C.tid)); C.lane = C.tid & 63;
    float* mod = (float*)(C.ws + WS_MOD);
    if (C.bid < 96) {
        LAS float* sc = (LAS float*)C.lds;
        LAS float* red = (LAS float*)(C.lds + 16384);
        for (int i = C.tid; i < 4096; i += 512) sc[i] = siluf_(C.c[i]);
        __syncthreads();
        const int col = C.bid * 64 + C.lane; float a0 = 0.f, a1 = 0.f, a2 = 0.f, a3 = 0.f;
        for (int k0 = C.wave * 128; k0 < C.wave * 128 + 128; k0 += 16) { float wv[16];
#pragma unroll
            for (int i = 0; i < 16; ++i) wv[i] = C.w_mod[(size_t)(k0 + i) * 6144 + col];
#pragma unroll
            for (int i = 0; i < 16; ++i) { const int k = k0 + i; a0 += sc[k] * wv[i]; a1 += sc[1024 + k] * wv[i]; a2 += sc[2048 + k] * wv[i]; a3 += sc[3072 + k] * wv[i]; } }
        red[(C.wave * 4 + 0) * 64 + C.lane] = a0; red[(C.wave * 4 + 1) * 64 + C.lane] = a1; red[(C.wave * 4 + 2) * 64 + C.lane] = a2; red[(C.wave * 4 + 3) * 64 + C.lane] = a3;
        __syncthreads();
        if (C.wave < 4) { float s = C.b_mod[col];
#pragma unroll
            for (int w = 0; w < 8; ++w) s += red[(w * 4 + C.wave) * 64 + C.lane];
            mod[C.wave * 6144 + col] = s; }
        __syncthreads();
    }
    LAS float* scr = (LAS float*)(C.lds + C.wave * 16384);
    constexpr int I_IN = 16 * 219, I_UQ = 8 * 48, I_UKV = 4 * 64, I_SQ = 16 * 32;
    constexpr int NITEMS = I_IN + I_UQ + I_UKV + 3 * I_SQ;
    bf16* win_t = (bf16*)(C.ws + WS_WIN);
    for (int it = C.gw; it < NITEMS; it += C.NGW) {
        int r = it;
        if (r < I_IN) { transpose_item(C.w_in, 1024, 7008, win_t, nullptr, scr, r, C.lane, [](int s) { return win_dest_row(s); }); continue; } r -= I_IN;
        if (r < I_UQ) { transpose_item(C.w_uq, 512, 1536, (bf16*)(C.ws + WS_WUQ), C.q_gain, scr, r, C.lane, [](int s) { return wuq_dest_row(s); }); continue; } r -= I_UQ;
        if (r < I_UKV) { transpose_item(C.w_ukv, 256, 2048, (bf16*)(C.ws + WS_WUKV), C.kv_gain, scr, r, C.lane, [](int s) { return s; }); continue; } r -= I_UKV;
        if (r < I_SQ) { transpose_item(C.w_o_dn, 1024, 1024, (bf16*)(C.ws + WS_WODN), nullptr, scr, r, C.lane, [](int s) { return s; }); continue; } r -= I_SQ;
        if (r < I_SQ) { transpose_item(C.w_o_mla, 1024, 1024, (bf16*)(C.ws + WS_WOMLA), nullptr, scr, r, C.lane, [](int s) { return s; }); continue; } r -= I_SQ;
        transpose_item(C.w_out, 1024, 1024, (bf16*)(C.ws + WS_WOUT), nullptr, scr, r, C.lane, [](int s) { return s; });
    }
    { v4u zz = {0u, 0u, 0u, 0u}; GAS v4u* p = (GAS v4u*)(win_t + (size_t)7008 * 1024);
      for (int i = C.bid * 512 + C.tid; i < 160 * 1024 / 8; i += C.G * 512) p[i] = zz; }
    if (C.bid == 0) for (int i = C.tid; i < 3072 * 2 / 16; i += 512) *(GAS v4u*)(C.ws + WS_ZROW + (size_t)i * 16) = (v4u){0u, 0u, 0u, 0u};
    { float* cs = (float*)(C.ws + WS_CS);
      for (int i = C.bid * 512 + C.tid; i < NTOK * 32; i += C.G * 512) { const int tok = i >> 5, k = i & 31;
          const float inv_freq = powf(10000.0f, -(float)k / 32.0f); const float ang = (float)C.positions[tok] * inv_freq;
          float s, c; sincosf(ang, &s, &c); cs[2 * i] = c; cs[2 * i + 1] = s; } }
}

__device__ __forceinline__ void p1_h(const Ctx& C0) {
    Ctx C = C0; asm volatile("" : "+v"(C.tid)); C.lane = C.tid & 63;
    const float* mod = (const float*)(C.ws + WS_MOD); bf16* h = (bf16*)(C.ws + WS_A);
    for (int m = C.gw; m < NTOK; m += C.NGW) { const int b = m / SEQ;
        const GAS f32x4* xr = (const GAS f32x4*)(C.x + (size_t)m * DM) + C.lane; f32x4 v[4]; float s = 0.f;
#pragma unroll
        for (int j = 0; j < 4; ++j) { v[j] = xr[64 * j]; s += (v[j].x * v[j].x + v[j].y * v[j].y) + (v[j].z * v[j].z + v[j].w * v[j].w); }
        const float rstd = rsqrtf(wave_sum(s) * (1.f / DM) + EPS);
        GAS v2u* o8 = (GAS v2u*)(h + (size_t)m * DM) + C.lane;
#pragma unroll
        for (int j = 0; j < 4; ++j) { const int col = 4 * C.lane + 256 * j;
            const f32x4 gm = *(const f32x4*)(C.g_mix + col), sh = *(const f32x4*)(mod + b * 6144 + col), sc = *(const f32x4*)(mod + b * 6144 + 1024 + col);
            const f32x4 y = v[j] * rstd * gm * (sc + 1.f) + sh; v2u w; w.x = pk2(y.x, y.y); w.y = pk2(y.z, y.w); o8[64 * j] = w; } }
}

__device__ __forceinline__ void p7_dnout(const Ctx& C0) {
    Ctx C = C0; asm volatile("" : "+v"(C.tid)); C.lane = C.tid & 63;
    const bf16* odir = (const bf16*)(C.ws + WS_ODIR); const bf16* z = (const bf16*)(C.ws + WS_Z); bf16* dno = (bf16*)C.out;
    for (int m = C.gw; m < NTOK; m += C.NGW) { const int c0 = C.lane * 16;
        f32x4 f[4], r[4], zz[4];
        { const GAS v4u* p = (const GAS v4u*)(odir + (size_t)m * 1024 + c0); unpack8(p[0], f[0], f[1]); unpack8(p[1], f[2], f[3]); }
        { const GAS v4u* p = (const GAS v4u*)(odir + ((size_t)NTOK + m) * 1024 + c0); unpack8(p[0], r[0], r[1]); unpack8(p[1], r[2], r[3]); }
        { const GAS v4u* p = (const GAS v4u*)(z + (size_t)m * 1024 + c0); unpack8(p[0], zz[0], zz[1]); unpack8(p[1], zz[2], zz[3]); }
        float s = 0.f;
#pragma unroll
        for (int j = 0; j < 4; ++j) { f[j] = f[j] + r[j]; s += (f[j].x * f[j].x + f[j].y * f[j].y) + (f[j].z * f[j].z + f[j].w * f[j].w); }
        s += __shfl_xor(s, 1); s += __shfl_xor(s, 2); s += __shfl_xor(s, 4);
        const float rstd = rsqrtf(s * (1.f / DHD) + EPS);
#pragma unroll
        for (int j = 0; j < 4; ++j) { const f32x4 og = *(const f32x4*)(C.dn_o_gain + (c0 & 127) + 4 * j);
#pragma unroll
            for (int e = 0; e < 4; ++e) f[j][e] = f[j][e] * rstd * og[e] * siluf_(zz[j][e]); }
        GAS v4u* o = (GAS v4u*)(dno + (size_t)m * 1024 + c0); o[0] = pack8(f[0], f[1]); o[1] = pack8(f[2], f[3]); }
}

__device__ __forceinline__ const bf16* x1_row(const unsigned char* ws, int m) { return (m < 8192) ? (const bf16*)(ws + WS_X1A) + (size_t)m * DM : (const bf16*)(ws + WS_X1B) + (size_t)(m - 8192) * DM; }
__device__ __forceinline__ f32x4 unpack4(const v2u w) { f32x4 r; r.x = bflo(w.x); r.y = bfhi(w.x); r.z = bflo(w.y); r.w = bfhi(w.y); return r; }
constexpr int RT_PITCH = 2064, RT_PART = 16 * RT_PITCH, RT_GA = 3 * RT_PART, RT_GB = RT_GA + 4096, RT_HS = RT_GB + 4096, RT_H = RT_HS + 512;
__device__ __forceinline__ void p11_h2(const Ctx& C0, int var = 0) {
    Ctx C = C0; asm volatile("" : "+v"(C.tid)); C.lane = C.tid & 63;
    const float* mod = (const float*)(C.ws + WS_MOD); bf16* h2 = (bf16*)(C.ws + WS_A); float* aff = (float*)(C.ws + WS_AFF);
    LAS unsigned char* L = C.lds; LAS float* GAl = (LAS float*)(L + RT_GA); LAS float* GBl = (LAS float*)(L + RT_GB); LAS float* HS = (LAS float*)(L + RT_HS); LAS float* Hl = (LAS float*)(L + RT_H);
    for (int blk = C.bid; blk < NTOK / 64; blk += C.G) { const int T0 = blk * 64, b = T0 / SEQ;
        for (int i = C.tid; i < DM; i += NWAVES * 64) { GAl[i] = C.g_ffn[i] * (mod[b * 6144 + 4096 + i] + 1.f); GBl[i] = mod[b * 6144 + 3072 + i]; }
        __syncthreads();
        { float hp = 0.f; const int e = C.tid & 15;
#pragma unroll 4
          for (int k = 0; k < 16; ++k) { const int cp = (C.tid + 512 * k) >> 4, c0 = 2 * cp; const float w0 = C.w_router[c0 * 16 + e], w1 = C.w_router[c0 * 16 + 16 + e];
              float g0 = GAl[c0] * w0, g1 = GAl[c0 + 1] * w1; hp += GBl[c0] * w0 + GBl[c0 + 1] * w1;
#pragma unroll
              for (int p = 0; p < 3; ++p) { const unsigned pk = pk2(g0, g1); *(LAS unsigned*)(L + p * RT_PART + e * RT_PITCH + c0 * 2) = pk; g0 -= bflo(pk); g1 -= bfhi(pk); } }
          hp += __shfl_xor(hp, 16); hp += __shfl_xor(hp, 32); if (C.lane < 16) HS[C.wave * 16 + C.lane] = hp; }
        __syncthreads();
        if (C.tid < 16) { float h = 0.f;
#pragma unroll
            for (int w = 0; w < NWAVES; ++w) h += HS[w * 16 + C.tid]; Hl[C.tid] = h; }
        __syncthreads();
        if (C.wave < 4) { int ln_ = C.lane; asm volatile("" : "+v"(ln_));
            const int tl = ln_ & 15, kg = ln_ >> 4, tok = T0 + 16 * C.wave + tl;
            const GAS v4u* xr = (const GAS v4u*)(x1_row(C.ws, tok) + 8 * kg);
            v4u xv[32];
#pragma unroll
            for (int s_ = 0; s_ < 32; ++s_) xv[s_] = xr[4 * s_];
            f32x4 acc = {0.f, 0.f, 0.f, 0.f}; float ssq = 0.f;
            const LAS unsigned char* gb_ = L + tl * RT_PITCH + 16 * kg;
#pragma unroll
            for (int s_ = 0; s_ < 32; ++s_) { const bf16x8 a = __builtin_bit_cast(bf16x8, xv[s_]);
#pragma unroll
                for (int p = 0; p < 3; ++p) acc = __builtin_amdgcn_mfma_f32_16x16x32_bf16(a, *(const LAS bf16x8*)(gb_ + p * RT_PART + 64 * s_), acc, 0, 0, 0);
                const v4u w = xv[s_]; const float x0 = bflo(w.x), x1_ = bfhi(w.x), x2 = bflo(w.y), x3 = bfhi(w.y), x4 = bflo(w.z), x5 = bfhi(w.z), x6 = bflo(w.w), x7 = bfhi(w.w);
                ssq += ((x0 * x0 + x1_ * x1_) + (x2 * x2 + x3 * x3)) + ((x4 * x4 + x5 * x5) + (x6 * x6 + x7 * x7));
                if (s_ & 1) asm volatile("" : "+v"(acc) :: "memory"); }
            ssq += __shfl_xor(ssq, 16); ssq += __shfl_xor(ssq, 32);
            const float rstd = rsqrtf(ssq * (1.f / DM) + EPS);
            GAS v4u* ho = (GAS v4u*)(h2 + (size_t)tok * DM + 8 * kg); const LAS unsigned char* gab_ = L + RT_GA + 32 * kg;
#pragma unroll
            for (int s_ = 0; s_ < 32; ++s_) { const f32x4 ga0 = *(const LAS f32x4*)(gab_ + 128 * s_), ga1 = *(const LAS f32x4*)(gab_ + 128 * s_ + 16), gb0 = *(const LAS f32x4*)(gab_ + 4096 + 128 * s_), gb1 = *(const LAS f32x4*)(gab_ + 4096 + 128 * s_ + 16);
                v4u w = xv[s_]; asm volatile("" : "+v"(w)); v4u o;
                o.x = pk2(bflo(w.x) * rstd * ga0[0] + gb0[0], bfhi(w.x) * rstd * ga0[1] + gb0[1]); o.y = pk2(bflo(w.y) * rstd * ga0[2] + gb0[2], bfhi(w.y) * rstd * ga0[3] + gb0[3]);
                o.z = pk2(bflo(w.z) * rstd * ga1[0] + gb1[0], bfhi(w.z) * rstd * ga1[1] + gb1[1]); o.w = pk2(bflo(w.w) * rstd * ga1[2] + gb1[2], bfhi(w.w) * rstd * ga1[3] + gb1[3]);
                if (!((var >> 18) & 1)) ho[4 * s_] = o;
                if (s_ & 1) asm volatile("" ::: "memory"); }
            const float he = Hl[tl];
#pragma unroll
            for (int r = 0; r < 4; ++r) { const float lgt = acc[r] * __shfl(rstd, 4 * kg + r) + he; float mx = lgt;
#pragma unroll
                for (int o = 1; o < 16; o <<= 1) mx = fmaxf(mx, __shfl_xor(mx, o));
                const float ex = __expf(lgt - mx); float den = ex;
#pragma unroll
                for (int o = 1; o < 16; o <<= 1) den += __shfl_xor(den, o);
                if (!((var >> 17) & 1)) aff[(size_t)(T0 + 16 * C.wave + 4 * kg + r) * NE + tl] = ex / den; } }
        __syncthreads(); }
}

__device__ __forceinline__ void p12_topk(const Ctx& C0) {
    Ctx C = C0; asm volatile("" : "+v"(C.tid)); C.lane = C.tid & 63;
    if (C.bid < NB * NE) {
        const float* aff = (const float*)(C.ws + WS_AFF); int* idx = (int*)(C.ws + WS_IDX) + C.bid * CAP; float* gatew = (float*)(C.ws + WS_GATEW) + C.bid * CAP;
        int* slot = (int*)(C.ws + WS_SLOT) + (size_t)C.bid * SEQ;
        LAS unsigned* hist = (LAS unsigned*)C.lds;
        LAS unsigned* sel = hist + 256;
        LAS unsigned* wsum = hist + 264;
        LAS int* lidx = (LAS int*)(hist + 512);
        unsigned key[8];
        { const GAS unsigned* p = (const GAS unsigned*)aff + ((size_t)(C.bid >> 4) * SEQ + C.tid * 8) * NE + (C.bid & 15);
#pragma unroll
          for (int j = 0; j < 8; ++j) key[j] = p[j * NE]; }
        unsigned prefix = 0u, krem = CAP;
        for (int pass = 0; pass < 4; ++pass) { const int shift = 24 - 8 * pass;
            if (C.tid < 256) hist[C.tid] = 0u;
            __syncthreads();
#pragma unroll
            for (int j = 0; j < 8; ++j) { const bool match = (pass == 0) || ((key[j] >> (shift + 8)) == prefix); if (match) __hip_atomic_fetch_add(&hist[(key[j] >> shift) & 255u], 1u, __ATOMIC_RELAXED, __HIP_MEMORY_SCOPE_WORKGROUP); }
            __syncthreads();
            if (C.wave == 0) { const unsigned c0 = hist[4 * C.lane], c1 = hist[4 * C.lane + 1], c2 = hist[4 * C.lane + 2], c3 = hist[4 * C.lane + 3]; const unsigned s = c0 + c1 + c2 + c3;
                unsigned suf = s;
#pragma unroll
                for (int o = 1; o < 64; o <<= 1) { const unsigned t2 = __shfl_down(suf, o); if (C.lane + o < 64) suf += t2; }
                const unsigned above = suf - s;
                if (above < krem && krem <= suf) { unsigned run = above; int bin;
                    if (run + c3 >= krem) bin = 3; else { run += c3; if (run + c2 >= krem) bin = 2; else { run += c2; if (run + c1 >= krem) bin = 1; else { run += c1; bin = 0; } } }
                    sel[0] = 4 * C.lane + bin; sel[1] = krem - run; } }
            __syncthreads();
            prefix = (prefix << 8) | sel[0]; krem = sel[1];
            __syncthreads();
        }
        unsigned ngt = 0u, neq = 0u;
#pragma unroll
        for (int j = 0; j < 8; ++j) { ngt += key[j] > prefix; neq += key[j] == prefix; }
        unsigned igt = ngt, ieq = neq;
#pragma unroll
        for (int o = 1; o < 64; o <<= 1) { const unsigned a = __shfl_up(igt, o), b2 = __shfl_up(ieq, o); if (C.lane >= o) { igt += a; ieq += b2; } }
        if (C.lane == 63) { wsum[C.wave * 2] = igt; wsum[C.wave * 2 + 1] = ieq; }
        __syncthreads();
        unsigned bgt = igt - ngt, beq = ieq - neq;
        for (int w = 0; w < C.wave; ++w) { bgt += wsum[w * 2]; beq += wsum[w * 2 + 1]; }
#pragma unroll
        for (int j = 0; j < 8; ++j) { const int t = C.tid * 8 + j; int sl = -1;
            if (key[j] > prefix) { sl = (int)(bgt + (beq < krem ? beq : krem)); ++bgt; }
            else if (key[j] == prefix) { if (beq < krem) sl = (int)(bgt + beq); ++beq; }
            slot[t] = sl; if (sl >= 0) { idx[sl] = (C.bid >> 4) * SEQ + t; gatew[sl] = __builtin_bit_cast(float, key[j]); } }
        __syncthreads();
    }
    LAS float* scr = (LAS float*)(C.lds + C.wave * 16384);
    bf16* wgu = (bf16*)(C.ws + WS_WGU); bf16* wd = (bf16*)(C.ws + WS_WD);
    const int nA = (16 * 3 * 512 * 8) / 10  , nB = 16 * 3 * 512 - nA, gwB = (C.bid - NB * NE) * NWAVES + C.wave, ngwB = (C.G - NB * NE) * NWAVES;
    const int cntA = (nA - C.gw + C.NGW - 1) / C.NGW, cntB = (C.bid >= NB * NE && ngwB > 0) ? (nB - gwB + ngwB - 1) / ngwB : 0;
    for (int q = 0; q < cntA + cntB; ++q) { const int it = (q < cntA) ? C.gw + q * C.NGW : nA + gwB + (q - cntA) * ngwB;
        const int e = it / 1536, r = it % 1536, which = r / 512, item = r % 512;
        if (which == 0) transpose_item(C.w_gate + (size_t)e * 1048576, 1024, 1024, wgu + (size_t)e * 2048 * 1024, nullptr, scr, item, C.lane, [](int s) { return 8 * (s >> 2) + (s & 3); });
        else if (which == 1) transpose_item(C.w_up + (size_t)e * 1048576, 1024, 1024, wgu + (size_t)e * 2048 * 1024, nullptr, scr, item, C.lane, [](int s) { return 8 * (s >> 2) + 4 + (s & 3); });
        else transpose_item(C.w_down + (size_t)e * 1048576, 1024, 1024, wd + (size_t)e * 1024 * 1024, nullptr, scr, item, C.lane, [](int s) { return s; }); }
}

__device__ __forceinline__ void p16_final(const Ctx& C0) {
    Ctx C = C0; asm volatile("" : "+v"(C.tid)); C.lane = C.tid & 63;
    const float* mod = (const float*)(C.ws + WS_MOD); const bf16* ye = (const bf16*)(C.ws + WS_YE); const int* slot = (const int*)(C.ws + WS_SLOT);
    typedef int i32x4 __attribute__((ext_vector_type(4)));
    for (int q = C.gw; q < NTOK / 4; q += C.NGW) { const int m0 = 4 * q, b = m0 / SEQ, t0 = m0 % SEQ;
        i32x4 s4 = {-1, -1, -1, -1};
        if (C.lane < NE) s4 = *(const GAS i32x4*)(slot + ((size_t)b * NE + C.lane) * SEQ + t0);
        f32x4 g2[4];
#pragma unroll
        for (int j = 0; j < 4; ++j) g2[j] = *(const f32x4*)(mod + b * 6144 + 5120 + 4 * C.lane + 256 * j);
        v2u xn[4];
        { const GAS v2u* xr0 = (const GAS v2u*)x1_row(C.ws, m0) + C.lane;
#pragma unroll
          for (int j = 0; j < 4; ++j) xn[j] = xr0[64 * j]; }
#pragma unroll
        for (int k = 0; k < 4; ++k) { const int m = m0 + k; const int myslot = s4[k];
            f32x4 v[4];
#pragma unroll
            for (int j = 0; j < 4; ++j) v[j] = unpack4(xn[j]);
            if (k < 3) { const GAS v2u* xr1 = (const GAS v2u*)x1_row(C.ws, m + 1) + C.lane;
#pragma unroll
                for (int j = 0; j < 4; ++j) xn[j] = xr1[64 * j]; }
            f32x4 acc[4];
#pragma unroll
            for (int j = 0; j < 4; ++j) acc[j] = (f32x4){0.f, 0.f, 0.f, 0.f};
            unsigned mask = (unsigned)__ballot(myslot >= 0) & 0xffffu;
            while (mask) { v2u w[4][4];
#pragma unroll
                for (int u = 0; u < 4; ++u) {
                    if (mask) { const int e = __ffs(mask) - 1; mask &= mask - 1u; const int sl = __shfl(myslot, e);
                        const GAS v2u* pp = (const GAS v2u*)(ye + ((size_t)(b * NE + e) * CAP + sl) * DM) + C.lane;
#pragma unroll
                        for (int j = 0; j < 4; ++j) w[u][j] = pp[64 * j]; }
                    else {
#pragma unroll
                        for (int j = 0; j < 4; ++j) w[u][j] = (v2u){0u, 0u}; } }
#pragma unroll
                for (int u = 0; u < 4; ++u)
#pragma unroll
                    for (int j = 0; j < 4; ++j) { acc[j].x += bflo(w[u][j].x); acc[j].y += bfhi(w[u][j].x); acc[j].z += bflo(w[u][j].y); acc[j].w += bfhi(w[u][j].y); } }
            float s = 0.f;
#pragma unroll
            for (int j = 0; j < 4; ++j) { v[j] = v[j] + g2[j] * acc[j]; s += (v[j].x * v[j].x + v[j].y * v[j].y) + (v[j].z * v[j].z + v[j].w * v[j].w); }
            const float rstd = rsqrtf(wave_sum(s) * (1.f / DM) + EPS);
            GAS f32x4* xr = (GAS f32x4*)(C.out + (size_t)m * DM) + C.lane;
#pragma unroll
            for (int j = 0; j < 4; ++j) { const f32x4 gf = *(const f32x4*)(C.g_final + 4 * C.lane + 256 * j); xr[64 * j] = v[j] * rstd * gf; } } }
}

#define SW128(row, boff) ((row) * 128 + ((boff) ^ ((((row) >> 1) & 7) << 4)))
#define SW256(row, boff) ((row) * 256 + ((boff) ^ (((row) & 15) << 4)))
typedef float f32x16 __attribute__((ext_vector_type(16)));
__device__ __forceinline__ int crow32(int r, int hi) { return (r & 3) + 8 * (r >> 2) + 4 * hi; }

template <int REV>
__device__ __forceinline__ void tri_solve_ip(LAS float* Lm, LAS bf16* Tl, int lane) {
    LAS float* colp = Lm + (REV ? 63 - lane : lane); asm volatile("" : "+v"(colp));
    LAS float* dummy = (LAS float*)Tl + lane;
#pragma unroll
    for (int R = 0; R < 4; ++R) {
        float a[16];
#pragma unroll
        for (int ii = 0; ii < 16; ++ii) a[ii] = 0.f;
        f32x4 lq_[2][16]; float xr_[2][4];
#define TS_LOAD(jg_, b_) do { _Pragma("unroll") for (int e = 0; e < 4; ++e) { const int jl = 4 * (jg_) + e; xr_[b_][e] = colp[(REV ? 63 - jl : jl) * 64]; } \
            _Pragma("unroll") for (int ii = 0; ii < 16; ++ii) { const int il = 16 * R + ii; lq_[b_][ii] = REV ? *(const LAS f32x4*)(Lm + (63 - il) * 64 + 60 - 4 * (jg_)) : *(const LAS f32x4*)(Lm + il * 64 + 4 * (jg_)); } } while (0)
        if (R > 0) TS_LOAD(0, 0);
#pragma unroll
        for (int jg = 0; jg < 4 * R; ++jg) { const int cb = jg & 1;
            if (jg + 1 < 4 * R) TS_LOAD(jg + 1, cb ^ 1);
            float xv[4];
#pragma unroll
            for (int e = 0; e < 4; ++e) { const int jl = 4 * jg + e; xv[e] = (lane < jl) ? xr_[cb][e] : ((lane == jl) ? 1.f : 0.f); }
#pragma unroll
            for (int ii = 0; ii < 16; ++ii) { const f32x4 l4 = lq_[cb][ii];
                a[ii] = fmaf(-(REV ? l4[3] : l4[0]), xv[0], a[ii]); a[ii] = fmaf(-(REV ? l4[2] : l4[1]), xv[1], a[ii]); a[ii] = fmaf(-(REV ? l4[1] : l4[2]), xv[2], a[ii]); a[ii] = fmaf(-(REV ? l4[0] : l4[3]), xv[3], a[ii]); }
            asm volatile("" : "+v"(a[0]), "+v"(a[1]), "+v"(a[2]), "+v"(a[3]), "+v"(a[4]), "+v"(a[5]), "+v"(a[6]), "+v"(a[7]), "+v"(a[8]), "+v"(a[9]), "+v"(a[10]), "+v"(a[11]), "+v"(a[12]), "+v"(a[13]), "+v"(a[14]), "+v"(a[15]) :: "memory");
        }
#undef TS_LOAD
        f32x4 p2[16][4];
#pragma unroll
        for (int ii = 1; ii < 16; ++ii) { const int il = 16 * R + ii;
#pragma unroll
            for (int q = 0; q < (ii + 3) / 4; ++q) { const int j0 = 16 * R + 4 * q; p2[ii][q] = REV ? *(const LAS f32x4*)(Lm + (63 - il) * 64 + 60 - j0) : *(const LAS f32x4*)(Lm + il * 64 + j0); } }
        float xb[16];
#pragma unroll
        for (int ii = 0; ii < 16; ++ii) { const int il = 16 * R + ii; float acc = a[ii] + ((lane == il) ? 1.f : 0.f), acc2 = 0.f;
#pragma unroll
            for (int q = 0; q < (ii + 3) / 4; ++q) { const f32x4 l4 = p2[ii][q];
                if (4 * q + 0 < ii) acc -= (REV ? l4[3] : l4[0]) * xb[4 * q + 0];
                if (4 * q + 1 < ii) acc2 -= (REV ? l4[2] : l4[1]) * xb[4 * q + 1];
                if (4 * q + 2 < ii) acc -= (REV ? l4[1] : l4[2]) * xb[4 * q + 2];
                if (4 * q + 3 < ii) acc2 -= (REV ? l4[0] : l4[3]) * xb[4 * q + 3]; }
            xb[ii] = acc + acc2; }
        asm volatile("" : "+v"(xb[15]) :: "memory");
#pragma unroll
        for (int ii = 0; ii < 16; ++ii) { const int il = 16 * R + ii; LAS float* wp = (lane < il) ? colp + (REV ? 63 - il : il) * 64 : dummy; *wp = xb[ii]; }
        asm volatile("" : "+v"(lane), "+v"(colp), "+v"(dummy) :: "memory");
    }
    int pc = lane; asm volatile("" : "+v"(pc));
    const LAS float* src = Lm + pc; LAS bf16* dst = Tl + pc;
#pragma unroll
    for (int i = 0; i < 64; ++i) { const float v = src[i * 64]; const bool mine = REV ? (pc > i) : (pc < i); dst[i * 64] = (bf16)f2bf(mine ? v : ((pc == i) ? 1.f : 0.f)); }
}
typedef short s16x4_t __attribute__((ext_vector_type(4)));

constexpr size_t T2_OFF = (size_t)NB * DNH * 64 * 2 * 4096;
constexpr int DN_RAW = 0, DN_KBUF = 53248, DN_LMAT = 69632, DN_GCS = 135168, DN_RNL = 139264;
__device__ __forceinline__ void p5_chunk(const Ctx& C0, int reps) {
    Ctx C = C0; asm volatile("" : "+v"(C.tid)); C.lane = C.tid & 63;
    bf16* qkv = (bf16*)(C.ws + WS_QKV); const bf16* halo = (const bf16*)(C.ws + WS_HALO); const bf16* zrow = (const bf16*)(C.ws + WS_ZROW);
    const float* beta = (const float*)(C.ws + WS_BETA); const float* gg = (const float*)(C.ws + WS_G); float* gcg = (float*)(C.ws + WS_GC); float* cbg = (float*)(C.ws + WS_CB); float* btg = (float*)(C.ws + WS_BT); bf16* Tbuf = (bf16*)C.out;
    LAS unsigned char* raw = C.lds + DN_RAW; LAS unsigned char* kbuf = C.lds + DN_KBUF; LAS float* rnl = (LAS float*)(C.lds + DN_RNL) + C.wave * 32;
    const int nun = (512 * reps - C.bid + C.G - 1) / C.G, nch = nun * 4;
#ifndef PROBE_VARIANT
#define PROBE_VARIANT 0
#endif
#define PV5(bit) (!wr && ((PROBE_VARIANT >> (bit)) & 1))
    v4u pre[7];
#define PRE_LOAD(q_) do { const int u1_ = C.bid + ((q_) >> 2) * C.G, u_ = u1_ & 511, n_ = (u_ & 15) * 4 + ((q_) & 3), h_ = (u_ >> 4) & 7, b_ = u_ >> 7, gch_ = b_ * 64 + n_; const size_t gr0_ = (size_t)b_ * SEQ + n_ * 64; \
        _Pragma("unroll") for (int it = 0; it < 7; ++it) { int idx = C.tid + 512 * it; if (it == 6 && idx >= 68 * 48) idx = 0; const int r = idx / 48, ch = idx % 48, col = (ch >> 4) * 1024 + h_ * 128 + (ch & 15) * 8; \
            const bf16* top = (n_ > 0) ? halo + (size_t)((gch_ - 1) * 4 + 2 + r) * 3072 : zrow; const bf16* bot = (n_ < 63) ? halo + (size_t)((gch_ + 1) * 4 + (r - 66)) * 3072 : zrow; \
            const bf16* mid = qkv + (gr0_ + r - 2) * 3072; const bf16* rowp = (r < 2) ? top : ((r >= 66) ? bot : mid); pre[it] = *(const GAS v4u*)(rowp + col); } } while (0)
    if (nch > 0) PRE_LOAD(0);
    for (int q = 0; q < nch; ++q) {
        const int u1 = C.bid + (q >> 2) * C.G, u = u1 & 511, c = q & 3; const bool wr = u1 < 512;
        const int grp = u & 15, h = (u >> 4) & 7, b = u >> 7, n = grp * 4 + c; const size_t gr0 = (size_t)b * SEQ + n * 64;
        int tid = C.tid; asm volatile("" : "+v"(tid)); const int lane = tid & 63;
        LAS float* gcs = (LAS float*)(C.lds + DN_GCS + c * 1024); LAS float* Lm = (LAS float*)(C.lds + DN_LMAT + c * 16384);
#pragma unroll
        for (int it = 0; it < 7; ++it) { const int idx = tid + 512 * it; if (it < 6 || idx < 68 * 48) { const int r = idx / 48, ch = idx % 48; *(LAS v4u*)(raw + r * 768 + ch * 16) = pre[it]; } }
        if (C.wave == 6) { float s = gg[(gr0 + lane) * 16 + h];
#pragma unroll
            for (int o = 1; o < 64; o <<= 1) { const float t2 = __shfl_up(s, o); if (lane >= o) s += t2; }
            const float bt_ = beta[(gr0 + lane) * 16 + h]; const size_t so_ = ((size_t)(0 * NB + b) * DNH + h) * SEQ + n * 64 + lane; gcs[lane] = s; gcs[128 + lane] = bt_; gcg[so_] = s; cbg[so_] = bt_ * __expf(s); btg[so_] = bt_; }
        if (C.wave == 7) { float s = gg[(gr0 + lane) * 16 + 8 + h];
#pragma unroll
            for (int o = 1; o < 64; o <<= 1) { const float t2 = __shfl_down(s, o); if (lane + o < 64) s += t2; }
            const float bt_ = beta[(gr0 + lane) * 16 + 8 + h]; const size_t so_ = ((size_t)(1 * NB + b) * DNH + h) * SEQ + n * 64 + lane; gcs[64 + lane] = s; gcs[192 + lane] = bt_; gcg[so_] = s; cbg[so_] = bt_ * __expf(s); btg[so_] = bt_; }
        __syncthreads();
        if (q + 1 < nch && !PV5(11)) PRE_LOAD(q + 1);
        if (C.wave < 6 && !PV5(8)) { const int ten = C.wave >> 1, rh = C.wave & 1, gcol = ten * 1024 + h * 128 + 2 * lane;
            float w0[5], w1[5];
#pragma unroll
            for (int k = 0; k < 5; ++k) { w0[k] = C.conv_w[k * 3072 + gcol]; w1[k] = C.conv_w[k * 3072 + gcol + 1]; }
            const LAS unsigned char* rp = raw + ten * 256 + lane * 4 + rh * 32 * 768;
            float y0[32], y1[32];
            { float x0[36], x1[36];
#pragma unroll
              for (int r = 0; r < 36; ++r) { const unsigned w = *(const LAS unsigned*)(rp + r * 768); x0[r] = bflo(w); x1[r] = bfhi(w); }
#pragma unroll
              for (int r = 0; r < 32; ++r) { float a0 = 0.f, a1 = 0.f;
#pragma unroll
                  for (int k = 0; k < 5; ++k) { a0 += w0[k] * x0[r + k]; a1 += w1[k] * x1[r + k]; }
                  y0[r] = siluf_(a0); y1[r] = siluf_(a1); } }
            if (ten < 2) {
                float t[32];
#pragma unroll
                for (int r = 0; r < 32; ++r) t[r] = y0[r] * y0[r] + y1[r] * y1[r];
#pragma unroll
                for (int lv = 0; lv < 5; ++lv) { const int half = 16 >> lv, bit = 32 >> lv; const bool up = (lane & bit) != 0;
#pragma unroll
                    for (int r = 0; r < half; ++r) { float lo_ = t[r], hi_ = t[r + half]; asm volatile("" : "+v"(lo_), "+v"(hi_));
                        const float give = up ? lo_ : hi_, keep = up ? hi_ : lo_; t[r] = keep + __shfl_xor(give, bit); } }
                const float tot = t[0] + __shfl_xor(t[0], 1);
                rnl[(lane >> 1) & 31] = rsqrtf(tot + EPS) * (ten == 0 ? 0.08838834764831845f : 1.f);
                LDS_WAIT();
#pragma unroll
                for (int r4 = 0; r4 < 8; ++r4) { const f32x4 rn = *(const LAS f32x4*)(rnl + 4 * r4);
#pragma unroll
                    for (int e = 0; e < 4; ++e) { y0[4 * r4 + e] *= rn[e]; y1[4 * r4 + e] *= rn[e]; } } }
            unsigned pk[32];
#pragma unroll
            for (int r = 0; r < 32; ++r) pk[r] = cvtpk_c(y0[r], y1[r]);
            if (wr) { bf16* op = qkv + (gr0 + rh * 32) * 3072 + gcol;
#pragma unroll
                for (int r = 0; r < 32; ++r) *(GAS unsigned*)(op + (size_t)r * 3072) = pk[r]; }
            if (ten == 1) {
#pragma unroll
                for (int r = 0; r < 32; ++r) *(LAS unsigned*)(kbuf + SW256(rh * 32 + r, 4 * lane)) = pk[r]; } }
        __syncthreads();
        if (!PV5(9)) {
            const int ti = C.wave >> 1; int lr = lane & 15, lq = lane >> 4; asm volatile("" : "+v"(lr), "+v"(lq));
            bf16x8 ka[4];
#pragma unroll
            for (int ks = 0; ks < 4; ++ks) ka[ks] = *(const LAS bf16x8*)(kbuf + SW256(ti * 16 + lr, (ks * 32 + 8 * lq) * 2));
#pragma unroll
            for (int t2 = 0; t2 < 2; ++t2) { const int tj = 2 * (C.wave & 1) + t2; f32x4 acc = {0.f, 0.f, 0.f, 0.f};
#pragma unroll
                for (int ks = 0; ks < 4; ++ks) acc = __builtin_amdgcn_mfma_f32_16x16x32_bf16(ka[ks], *(const LAS bf16x8*)(kbuf + SW256(tj * 16 + lr, (ks * 32 + 8 * lq) * 2)), acc, 0, 0, 0);
                const int j = tj * 16 + lr; const float gfj = gcs[j], gbj = gcs[64 + j];
#pragma unroll
                for (int r = 0; r < 4; ++r) { const int i = ti * 16 + 4 * lq + r; float val = 0.f;
                    if (i > j) val = gcs[128 + i] * acc[r] * __expf(gcs[i] - gfj);
                    else if (i < j) val = gcs[192 + i] * acc[r] * __expf(gcs[64 + i] - gbj);
                    Lm[i * 64 + j] = val; } } }
        __syncthreads();
        if (c == 3 && !PV5(10)) {
            const int cs = C.wave >> 1, dir = C.wave & 1, ns = grp * 4 + cs; const LAS float* Ls = (const LAS float*)(C.lds + DN_LMAT + cs * 16384);
            bf16* Tg = Tbuf + ((size_t)(((b * DNH + h) * 64 + ns) * 2 + dir)) * 4096;
            LAS bf16* Tl = (LAS bf16*)(C.lds + C.wave * 8192);
            int ln = C.lane; asm volatile("" : "+v"(ln));
            if (dir == 0) tri_solve_ip<0>((LAS float*)Ls, Tl, ln); else tri_solve_ip<1>((LAS float*)Ls, Tl, ln);
            LDS_WAIT();
            const LAS unsigned char* tsrc = (const LAS unsigned char*)Tl + ln * 16; bf16* tdst = Tg + ln * 8;
            if (wr) { _Pragma("unroll") for (int q2 = 0; q2 < 8; ++q2) *(GAS v4u*)(tdst + q2 * 512) = *(const LAS v4u*)(tsrc + q2 * 1024); }
            { const LAS float* gcs2 = (const LAS float*)(C.lds + DN_GCS + cs * 1024); const float cbv = gcs2[128 + 64 * dir + ln] * __expf(gcs2[64 * dir + ln]);
              const LAS float* src = Ls + ln; LAS bf16* dst = Tl + ln;
#pragma unroll
              for (int i2 = 0; i2 < 64; ++i2) { const float v = src[i2 * 64]; const bool mine = dir ? (ln > i2) : (ln < i2); dst[i2 * 64] = (bf16)f2bf((mine ? v : ((ln == i2) ? 1.f : 0.f)) * cbv); }
              LDS_WAIT();
              if (wr) { _Pragma("unroll") for (int q2 = 0; q2 < 8; ++q2) *(GAS v4u*)(tdst + T2_OFF + q2 * 512) = *(const LAS v4u*)(tsrc + q2 * 1024); } }
            __syncthreads();
        }
    }
#undef PRE_LOAD
}

constexpr int SC_K0 = 0, SC_Q0 = 32768, SC_T = 65536, SC_T2 = 73728, SC_V = 81920, SC_SC0 = 86016, SC_W = 88064, SC_IT = 104448, SC_UT = 112640, SC_ST = 120832, SC_VT = 129024, SC_VST = 133120, SC_OB = 137216;
typedef short s16x4_t __attribute__((ext_vector_type(4)));
__device__ __forceinline__ s16x4_t tr_rd(unsigned addr) { return __builtin_amdgcn_ds_read_tr16_b64_v4i16((LAS s16x4_t*)(uintptr_t)addr); }
__device__ __forceinline__ bf16x8 cat4(s16x4_t a, s16x4_t b) { return (bf16x8){a[0], a[1], a[2], a[3], b[0], b[1], b[2], b[3]}; }
#define SWU(row, chunk) ((row) * 256 + ((((chunk) ^ (row)) & 15) * 16))
__device__ __forceinline__ void p6_scan(const Ctx& C0, int reps) {
    Ctx C = C0; asm volatile("" : "+v"(C.tid)); C.lane = C.tid & 63;
    const bf16* qkv = (const bf16*)(C.ws + WS_QKV); const float* gcg = (const float*)(C.ws + WS_GC); const float* btg = (const float*)(C.ws + WS_BT);
    const bf16* Tbuf = (const bf16*)C.out; bf16* odir = (bf16*)(C.ws + WS_ODIR);
    LAS unsigned char* L = C.lds; const unsigned Lb = (unsigned)(uintptr_t)L;
    const int w = C.wave, lr = C.lane & 15, lq = C.lane >> 4, tq = lr >> 2, tp = lr & 3, rt = w >> 1, ct = w & 1;
    for (int u1 = C.bid; u1 < 256 * reps; u1 += C.G) { const int u0 = u1 & 255; const bool dry = u1 >= 256;
#define PVX(bit) (dry && ((PROBE_VARIANT >> (bit)) & 1))
        int dvs, seq; if (C.G == 256) { const int xcd = u0 & 7, j = u0 >> 3; dvs = j & 3; seq = (j >> 2) * 8 + xcd; } else { dvs = u0 & 3; seq = u0 >> 2; }
        const int dir = seq & 1, h = (seq >> 1) & 7, b = seq >> 4;
        f32x4 accS[2] = {{0.f, 0.f, 0.f, 0.f}, {0.f, 0.f, 0.f, 0.f}};
        v4u sk0, sk1, sq0, sq1, st0, st2, sv0; float sgc = 0.f, sbt = 0.f;
        const int ki = C.tid >> 4, kc8 = (C.tid & 15) * 8, ti_ = C.tid >> 3, tc8 = (C.tid & 7) * 8, vi = (C.tid & 255) >> 2, vc8 = (C.tid & 3) * 8;
        const size_t seqoff = ((size_t)(dir * NB + b) * DNH + h) * SEQ;
#define SC_LOAD(n_) do { const size_t gr0_ = (size_t)b * SEQ + (size_t)(n_) * 64; const bf16* kb_ = qkv + gr0_ * 3072 + 1024 + h * 128; const bf16* qb_ = qkv + gr0_ * 3072 + h * 128; \
        const bf16* tb_ = Tbuf + ((size_t)(((b * DNH + h) * 64 + (n_)) * 2 + dir)) * 4096 + ti_ * 64 + tc8; \
        sk0 = *(const GAS v4u*)(kb_ + (size_t)ki * 3072 + kc8); sk1 = *(const GAS v4u*)(kb_ + (size_t)(ki + 32) * 3072 + kc8); \
        sq0 = *(const GAS v4u*)(qb_ + (size_t)ki * 3072 + kc8); sq1 = *(const GAS v4u*)(qb_ + (size_t)(ki + 32) * 3072 + kc8); \
        st0 = *(const GAS v4u*)(tb_); st2 = *(const GAS v4u*)(tb_ + T2_OFF); \
        if (C.tid >= 256) { sv0 = *(const GAS v4u*)(qkv + (gr0_ + vi) * 3072 + 2048 + h * 128 + dvs * 32 + vc8); sbt = btg[seqoff + (n_) * 64 + vi]; } \
        if (C.tid < 64) sgc = gcg[seqoff + (n_) * 64 + C.tid]; } while (0)
#define SC_WRITE(buf_) do { LAS unsigned char* K_ = L + SC_K0 + (buf_) * 16384; LAS unsigned char* Q_ = L + SC_Q0 + (buf_) * 16384; \
        *(LAS v4u*)(K_ + SW256(ki, kc8 * 2)) = sk0; *(LAS v4u*)(K_ + SW256(ki + 32, kc8 * 2)) = sk1; \
        *(LAS v4u*)(Q_ + SW256(ki, kc8 * 2)) = sq0; *(LAS v4u*)(Q_ + SW256(ki + 32, kc8 * 2)) = sq1; \
        *(LAS v4u*)(L + SC_T + SW128(ti_, tc8 * 2)) = st0; *(LAS v4u*)(L + SC_T2 + SW128(ti_, tc8 * 2)) = st2; \
        if (C.tid >= 256) { f32x4 va, vb; unpack8(sv0, va, vb); *(LAS v4u*)(L + SC_V + vi * 64 + vc8 * 2) = pack8(va * sbt, vb * sbt); } \
        if (C.tid < 64) { LAS float* sc_ = (LAS float*)(L + SC_SC0 + (buf_) * 1024); const float gl_ = __shfl(sgc, dir ? 0 : 63); sc_[C.tid] = sgc; sc_[64 + C.tid] = __expf(sgc); sc_[128 + C.tid] = __expf(gl_ - sgc); if (C.tid == 0) sc_[192] = __expf(gl_); } } while (0)
#define SC_PRODUCE_WU(kb_) do { const unsigned Kb_ = Lb + SC_K0 + (kb_) * 16384; \
        const s16x4_t k0 = tr_rd(Kb_ + SW256(8 * lq + tq, (w * 16 + 4 * tp) * 2)), k1 = tr_rd(Kb_ + SW256(8 * lq + 4 + tq, (w * 16 + 4 * tp) * 2)); \
        const s16x4_t k2 = tr_rd(Kb_ + SW256(32 + 8 * lq + tq, (w * 16 + 4 * tp) * 2)), k3 = tr_rd(Kb_ + SW256(32 + 8 * lq + 4 + tq, (w * 16 + 4 * tp) * 2)); \
        const bf16x8 ka_ = cat4(k0, k1), kb2_ = cat4(k2, k3); \
        _Pragma("unroll") for (int it = 0; it < 4; ++it) { \
            const bf16x8 bt0 = *(const LAS bf16x8*)(L + SC_T2 + SW128(it * 16 + lr, (8 * lq) * 2)), bt1 = *(const LAS bf16x8*)(L + SC_T2 + SW128(it * 16 + lr, (32 + 8 * lq) * 2)); \
            f32x4 a4 = __builtin_amdgcn_mfma_f32_16x16x32_bf16(ka_, bt0, (f32x4){0.f, 0.f, 0.f, 0.f}, 0, 0, 0); a4 = __builtin_amdgcn_mfma_f32_16x16x32_bf16(kb2_, bt1, a4, 0, 0, 0); \
            v2u pw_; pw_.x = cvtpk_c(a4[0], a4[1]); pw_.y = cvtpk_c(a4[2], a4[3]); *(LAS v2u*)(L + SC_W + SW256(it * 16 + lr, (w * 16 + 4 * lq) * 2)) = pw_; } \
        const bf16x8 at0 = *(const LAS bf16x8*)(L + SC_T + SW128(rt * 16 + lr, (8 * lq) * 2)), at1 = *(const LAS bf16x8*)(L + SC_T + SW128(rt * 16 + lr, (32 + 8 * lq) * 2)); \
        const s16x4_t v0 = tr_rd(Lb + SC_V + (8 * lq + tq) * 64 + (ct * 16 + 4 * tp) * 2), v1 = tr_rd(Lb + SC_V + (8 * lq + 4 + tq) * 64 + (ct * 16 + 4 * tp) * 2); \
        const s16x4_t v2 = tr_rd(Lb + SC_V + (32 + 8 * lq + tq) * 64 + (ct * 16 + 4 * tp) * 2), v3 = tr_rd(Lb + SC_V + (32 + 8 * lq + 4 + tq) * 64 + (ct * 16 + 4 * tp) * 2); \
        f32x4 u4 = __builtin_amdgcn_mfma_f32_16x16x32_bf16(at0, cat4(v0, v1), (f32x4){0.f, 0.f, 0.f, 0.f}, 0, 0, 0); u4 = __builtin_amdgcn_mfma_f32_16x16x32_bf16(at1, cat4(v2, v3), u4, 0, 0, 0); \
        *(LAS f32x4*)(L + SC_UT + SWU(ct * 16 + lr, rt * 4 + lq)) = u4; } while (0)
        __syncthreads();
        for (int i = C.tid; i < 8192 / 16; i += 512) *(LAS v4u*)(L + SC_ST + i * 16) = (v4u){0u, 0u, 0u, 0u};
        SC_LOAD(dir ? 63 : 0); SC_WRITE(0); SC_LOAD(dir ? 62 : 1);
        __syncthreads();
        SC_PRODUCE_WU(0);
        __syncthreads();
        for (int cc = 0; cc < 64; ++cc) {
            const int n = dir ? 63 - cc : cc, kb = cc & 1;
            LAS unsigned char* Kc = L + SC_K0 + kb * 16384; LAS unsigned char* Qc = L + SC_Q0 + kb * 16384; const LAS float* sc = (const LAS float*)(L + SC_SC0 + kb * 1024);
            const int i0 = rt * 16 + 4 * lq;
            if (!dry && cc > 0 && C.tid < 256) { const size_t grp_ = (size_t)b * SEQ + (size_t)(dir ? n + 1 : n - 1) * 64;
                *(GAS v4u*)(odir + ((size_t)dir * NTOK + grp_ + vi) * 1024 + h * 128 + dvs * 32 + vc8) = *(const LAS v4u*)(L + SC_OB + vi * 64 + vc8 * 2); }
            f32x4 accQ = {0.f, 0.f, 0.f, 0.f};
            if (!PVX(3)) {
                f32x4 accV = -*(const LAS f32x4*)(L + SC_UT + SWU(ct * 16 + lr, rt * 4 + lq));
                bf16x8 aq[4];
#pragma unroll
                for (int ks = 0; ks < 4; ++ks) { const int bo = (ks * 32 + 8 * lq) * 2; aq[ks] = *(const LAS bf16x8*)(Qc + SW256(rt * 16 + lr, bo));
                    const bf16x8 aw = *(const LAS bf16x8*)(L + SC_W + SW256(rt * 16 + lr, bo)), bs = *(const LAS bf16x8*)(L + SC_ST + SW256(ct * 16 + lr, bo));
                    accV = __builtin_amdgcn_mfma_f32_16x16x32_bf16(aw, bs, accV, 0, 0, 0); accQ = __builtin_amdgcn_mfma_f32_16x16x32_bf16(aq[ks], bs, accQ, 0, 0, 0); }
                const f32x4 di = *(const LAS f32x4*)(sc + 128 + i0); const f32x4 vn = -accV; v2u pw, qw; pw.x = cvtpk_c(vn[0], vn[1]); pw.y = cvtpk_c(vn[2], vn[3]);
                qw.x = cvtpk_c(vn[0] * di[0], vn[1] * di[1]); qw.y = cvtpk_c(vn[2] * di[2], vn[3] * di[3]);
                *(LAS v2u*)(L + SC_VT + SW128(ct * 16 + lr, i0 * 2)) = pw; *(LAS v2u*)(L + SC_VST + SW128(ct * 16 + lr, i0 * 2)) = qw;
                const float gci = sc[rt * 16 + lr]; const int ii = rt * 16 + lr;
#pragma unroll
                for (int t2 = 0; t2 < 2; ++t2) { const int jt = 2 * ct + t2; v2u iw; iw.x = 0u; iw.y = 0u;
                    if (!PVX(5) && (dir ? (jt >= rt) : (jt <= rt))) { f32x4 a4 = {0.f, 0.f, 0.f, 0.f};
#pragma unroll
                        for (int ks = 0; ks < 4; ++ks) a4 = __builtin_amdgcn_mfma_f32_16x16x32_bf16(*(const LAS bf16x8*)(Kc + SW256(jt * 16 + lr, (ks * 32 + 8 * lq) * 2)), aq[ks], a4, 0, 0, 0);
                        const f32x4 gj = *(const LAS f32x4*)(sc + jt * 16 + 4 * lq); float pv[4];
#pragma unroll
                        for (int r = 0; r < 4; ++r) { const int jj = jt * 16 + 4 * lq + r; const bool keep = (jt != rt) || (dir ? (ii <= jj) : (ii >= jj)); pv[r] = keep ? a4[r] * __expf(gci - gj[r]) : 0.f; }
                        iw.x = cvtpk_c(pv[0], pv[1]); iw.y = cvtpk_c(pv[2], pv[3]); }
                    *(LAS v2u*)(L + SC_IT + SW128(ii, (jt * 16 + 4 * lq) * 2)) = iw; } }
            if (cc + 1 < 64 && !PVX(4)) SC_WRITE(kb ^ 1);
            if (cc + 2 < 64 && !PVX(0)) SC_LOAD(dir ? 61 - cc : cc + 2);
            if (!PVX(1)) __syncthreads();
            if (!PVX(6)) {
                const bf16x8 ai0 = *(const LAS bf16x8*)(L + SC_IT + SW128(rt * 16 + lr, (8 * lq) * 2)), ai1 = *(const LAS bf16x8*)(L + SC_IT + SW128(rt * 16 + lr, (32 + 8 * lq) * 2));
                const f32x4 ei = *(const LAS f32x4*)(sc + 64 + i0);
                f32x4 accO = __builtin_amdgcn_mfma_f32_16x16x32_bf16(ai0, *(const LAS bf16x8*)(L + SC_VT + SW128(ct * 16 + lr, (8 * lq) * 2)), (f32x4){0.f, 0.f, 0.f, 0.f}, 0, 0, 0);
                accO = __builtin_amdgcn_mfma_f32_16x16x32_bf16(ai1, *(const LAS bf16x8*)(L + SC_VT + SW128(ct * 16 + lr, (32 + 8 * lq) * 2)), accO, 0, 0, 0);
                const unsigned o01 = cvtpk_c(accO[0] + ei[0] * accQ[0], accO[1] + ei[1] * accQ[1]), o23 = cvtpk_c(accO[2] + ei[2] * accQ[2], accO[3] + ei[3] * accQ[3]);
                LAS unsigned short* ob = (LAS unsigned short*)(L + SC_OB) + i0 * 32 + ct * 16 + lr;
                ob[0] = (unsigned short)(o01 & 0xffffu); ob[32] = (unsigned short)(o01 >> 16); ob[64] = (unsigned short)(o23 & 0xffffu); ob[96] = (unsigned short)(o23 >> 16); }
            if (cc + 1 < 64 && !PVX(2)) SC_PRODUCE_WU(kb ^ 1);
            if (!PVX(7)) {
                const float egl = sc[192]; const unsigned Kb = Lb + SC_K0 + kb * 16384;
                const s16x4_t k0 = tr_rd(Kb + SW256(8 * lq + tq, (w * 16 + 4 * tp) * 2)), k1 = tr_rd(Kb + SW256(8 * lq + 4 + tq, (w * 16 + 4 * tp) * 2));
                const s16x4_t k2 = tr_rd(Kb + SW256(32 + 8 * lq + tq, (w * 16 + 4 * tp) * 2)), k3 = tr_rd(Kb + SW256(32 + 8 * lq + 4 + tq, (w * 16 + 4 * tp) * 2));
                const bf16x8 ka = cat4(k0, k1), kbb = cat4(k2, k3);
#pragma unroll
                for (int c2 = 0; c2 < 2; ++c2) { accS[c2] = accS[c2] * egl;
                    accS[c2] = __builtin_amdgcn_mfma_f32_16x16x32_bf16(ka, *(const LAS bf16x8*)(L + SC_VST + SW128(c2 * 16 + lr, (8 * lq) * 2)), accS[c2], 0, 0, 0);
                    accS[c2] = __builtin_amdgcn_mfma_f32_16x16x32_bf16(kbb, *(const LAS bf16x8*)(L + SC_VST + SW128(c2 * 16 + lr, (32 + 8 * lq) * 2)), accS[c2], 0, 0, 0);
                    v2u pw; pw.x = cvtpk_c(accS[c2][0], accS[c2][1]); pw.y = cvtpk_c(accS[c2][2], accS[c2][3]);
                    *(LAS v2u*)(L + SC_ST + SW256(c2 * 16 + lr, (w * 16 + 4 * lq) * 2)) = pw; } }
            if (!PVX(1)) __syncthreads();
        }
        if (!dry && C.tid < 256) { const size_t grp_ = (size_t)b * SEQ + (size_t)(dir ? 0 : 63) * 64;
            *(GAS v4u*)(odir + ((size_t)dir * NTOK + grp_ + vi) * 1024 + h * 128 + dvs * 32 + vc8) = *(const LAS v4u*)(L + SC_OB + vi * 64 + vc8 * 2); }
#undef SC_LOAD
#undef SC_WRITE
#undef SC_PRODUCE_WU
    }
}

constexpr int N_PHASES = 16;
struct Args { const void* in[24]; float* out; unsigned char* ws; int ph_lo, ph_hi; };
__global__ void __launch_bounds__(NWAVES * 64, 2) fwd(Args args) {
    extern __shared__ __attribute__((aligned(16))) unsigned char lds[];
    Ctx C;
    C.lds = (LAS unsigned char*)lds; C.ws = args.ws; C.out = args.out;
    C.tid = threadIdx.x; C.lane = C.tid & 63; C.wave = __builtin_amdgcn_readfirstlane(C.tid >> 6); C.G = gridDim.x; C.bid = blockIdx.x;
    C.gw = C.bid * NWAVES + C.wave; C.NGW = C.G * NWAVES;
    C.x = (const float*)args.in[0]; C.c = (const float*)args.in[1]; C.positions = (const int*)args.in[2]; C.w_mod = (const float*)args.in[3]; C.b_mod = (const float*)args.in[4];
    C.g_mix = (const float*)args.in[5]; C.w_in = (const float*)args.in[6]; C.conv_w = (const float*)args.in[7]; C.a_log = (const float*)args.in[8]; C.dt_bias = (const float*)args.in[9];
    C.dn_o_gain = (const float*)args.in[10]; C.q_gain = (const float*)args.in[11]; C.w_uq = (const float*)args.in[12]; C.kv_gain = (const float*)args.in[13]; C.w_ukv = (const float*)args.in[14];
    C.w_o_dn = (const float*)args.in[15]; C.w_o_mla = (const float*)args.in[16]; C.w_out = (const float*)args.in[17]; C.g_ffn = (const float*)args.in[18]; C.w_router = (const float*)args.in[19];
    C.w_gate = (const float*)args.in[20]; C.w_up = (const float*)args.in[21]; C.w_down = (const float*)args.in[22]; C.g_final = (const float*)args.in[23];
    unsigned char* ws = args.ws;
    gu32* ctl = (gu32*)(ws + WS_CTL);
    volatile LAS unsigned* MISC = (volatile LAS unsigned*)(C.lds + MISC_OFF);
    for (int u = C.tid; u < (LDS_BYTES - LDSCTL_OFF) / 4; u += NWAVES * 64) ((LAS unsigned*)(C.lds + LDSCTL_OFF))[u] = 0u;
    __syncthreads();
    XcdBarrier bar; bar.bar = (unsigned*)(ctl + CW_BAR); bar.x = 0; bar.st = nullptr;
#if !MK_PER_PHASE
    bar = xcd_barrier_post((unsigned*)(ctl + CW_BAR), MISC + 8);
#endif
    const int lo = args.ph_lo, hi = args.ph_hi & 0xff, p5reps = 1 + ((args.ph_hi >> 8) & 1);
#ifndef PH_MASK
#define PH_MASK 0xFFFFFFFFu
#endif
#define IN(k) (((PH_MASK >> (k)) & 1u) && lo <= (k) && (k) < hi)
#ifndef PROBE_MASK
#define PROBE_MASK 0u
#endif
#define REP(k) (((PROBE_MASK >> (k)) & 1u) != 0u)
#define PHASE(k, ...) if (IN(k)) { __VA_ARGS__ if (REP(k) && !((0x637Cu >> (k)) & 1u)) { __syncthreads(); __VA_ARGS__ } }
#define NREP(k) (REP(k) ? 2 : 1)
#if MK_PER_PHASE
#define SEAM(k) do { } while (0)
#else
#define SEAM(k) do { if (IN(k) && IN((k) + 1)) xcd_barrier(bar); } while (0)
#endif
    bf16* const A_ = (bf16*)(ws + WS_A);

    PHASE(0,  p0_prologue(C); ) SEAM(0);
    PHASE(1,  p1_h(C); ) SEAM(1);
    PHASE(2,
        pg8::Gemm g{A_, (const bf16*)(ws + WS_WIN), NTOK, NPROJ, 1024}; pg8::StaticOrder S; S.init(NTOK, NPROJ, C.G, C.bid, NREP(2));
        EpiProj E{(bf16*)(ws + WS_QKV), (bf16*)(ws + WS_Z), (bf16*)(ws + WS_GATES), (bf16*)(ws + WS_CQ), (bf16*)(ws + WS_CKV), (bf16*)(ws + WS_HALO), (bf16*)(ws + WS_KROPE),
                  (float*)(ws + WS_SSQQ), (float*)(ws + WS_SSQKV), (float*)(ws + WS_BETA), (float*)(ws + WS_G), (const float*)(ws + WS_CS), C.a_log, C.dt_bias};
        pg8::gemm_phase<EpiProj, pg8::StaticOrder, true, true>(C.lds, g, S, E);
    ) SEAM(2);
    PHASE(3,
        { pg8::Gemm g{(const bf16*)(ws + WS_CQ), (const bf16*)(ws + WS_WUQ), NTOK, 1536, QL}; pg8::StaticOrder S; S.init(NTOK, 1536, C.G, C.bid, NREP(3));
          EpiQ E{A_, (const float*)(ws + WS_SSQQ), (const float*)(ws + WS_CS)};
          pg8::gemm_phase<EpiQ, pg8::StaticOrder, true, true>(C.lds, g, S, E); }
        { pg8::Gemm g{(const bf16*)(ws + WS_CKV), (const bf16*)(ws + WS_WUKV), NTOK, 2048, KVL}; KvOrder S; S.init(C.G, C.bid, NREP(3));
          EpiKV E{(bf16*)C.out, (const float*)(ws + WS_SSQKV)};
          pg8::gemm_phase<EpiKV, KvOrder, true, true>(C.lds, g, S, E); }
    ) SEAM(3);
    PHASE(4,
        const bf16* Q = A_; const bf16* KV = (const bf16*)C.out; const bf16* KR = (const bf16*)(ws + WS_KROPE); bf16* O = (bf16*)(ws + WS_OMLA);
        const int xcd = C.bid & 7, j = C.bid >> 3;
        if (C.G == 256) {
            for (int i2 = 0; i2 < 2 * NREP(4); ++i2) { const int i = i2 & 1; const int bh = i * 16 + xcd * 2 + (j >> 4), qb = j & 15, b = bh >> 3, h = bh & 7; const size_t r0 = (size_t)b * SEQ;
                att::attn_unit(Q + (r0 + qb * 256) * 1536 + h * QKD, KV + r0 * 2048 + h * 256, KV + r0 * 2048 + h * 256 + 128, KR + r0 * 64, O + (r0 + qb * 256) * 1024 + h * 128, SEQ, (char*)lds, i2 >= 2); }
        } else {
            for (int u = C.bid; u < 512; u += C.G) { const int bh = u >> 4, qb = u & 15, b = bh >> 3, h = bh & 7; const size_t r0 = (size_t)b * SEQ;
                att::attn_unit(Q + (r0 + qb * 256) * 1536 + h * QKD, KV + r0 * 2048 + h * 256, KV + r0 * 2048 + h * 256 + 128, KR + r0 * 64, O + (r0 + qb * 256) * 1024 + h * 128, SEQ, (char*)lds); }
        }
    ) SEAM(4);
    PHASE(5,  p5_chunk(C, p5reps); ) SEAM(5);
    PHASE(6,  p6_scan(C, NREP(6)); ) SEAM(6);
#ifdef PROBE_XBAR
    if (IN(6) && IN(7)) { for (int xb_ = 0; xb_ < PROBE_XBAR; ++xb_) xcd_barrier(bar); }
#endif
    PHASE(7,  p7_dnout(C); ) SEAM(7);
    PHASE(8,
        pg8::Gemm g{(const bf16*)C.out, (const bf16*)(ws + WS_WODN), NTOK, 1024, 1024, nullptr, (const bf16*)(ws + WS_OMLA), (const bf16*)(ws + WS_WOMLA)}; PairOrder S; S.init(NTOK, 1024, C.G, C.bid, NREP(8));
        EpiMixZ E{(bf16*)(ws + WS_Z), (const bf16*)(ws + WS_GATES)};
        pg8::gemm_phase<EpiMixZ, PairOrder, true, true>(C.lds, g, S, E);
    ) SEAM(8);
    PHASE(9,
        pg8::Gemm g{(const bf16*)(ws + WS_Z), (const bf16*)(ws + WS_WOUT), NTOK, 1024, 1024}; pg8::StaticOrder S; S.init(NTOK, 1024, C.G, C.bid, NREP(9));
        EpiOut E{ws, C.x, (const float*)(ws + WS_MOD)};
        pg8::gemm_phase<EpiOut, pg8::StaticOrder, true, true>(C.lds, g, S, E);
    ) SEAM(9);
    int p10var = 0;
    PHASE(10,  p11_h2(C, p10var); p10var = PROBE_VARIANT; ) SEAM(10);
    PHASE(11,  p12_topk(C); ) if (IN(11) && IN(13)) xcd_barrier(bar);
    PHASE(13,
        pg8::Gemm g{(const bf16*)(ws + WS_A), (const bf16*)(ws + WS_WGU), 64 * CAP, 16 * 2048, 1024, (const int*)(ws + WS_IDX)}; MoeOrder S; S.init(8, C.G, C.bid, NREP(13));
        EpiGU E{(bf16*)(ws + WS_HID)};
        pg8::gemm_phase<EpiGU, MoeOrder, true, true, true>(C.lds, g, S, E);
    ) SEAM(13);
    PHASE(14,
        pg8::Gemm g{(const bf16*)(ws + WS_HID), (const bf16*)(ws + WS_WD), 64 * CAP, 16 * 1024, 1024}; MoeOrder S; S.init(4, C.G, C.bid, NREP(14));
        EpiDown E{(bf16*)(ws + WS_YE), (const float*)(ws + WS_GATEW)};
        pg8::gemm_phase<EpiDown, MoeOrder, true, true>(C.lds, g, S, E);
    ) SEAM(14);
    PHASE(15,  p16_final(C); )
#undef IN
#undef SEAM
}

extern "C" void kernel_launch(void* const* d_in, const int* in_sizes, int n_in, void* d_out, int out_size, void* d_ws, size_t ws_size, hipStream_t stream) {
    static int grid = 0;
    if (grid == 0) {
        if (n_in != 24 || out_size != NTOK * DM || ws_size < WS_END) { fprintf(stderr, "kernel_launch: unexpected shapes: n_in %d out %d ws %zu (need %zu)\n", n_in, out_size, ws_size, (size_t)WS_END); grid = -1; return; }
        int dev = 0, cus = 0, per_cu = 0;
        if (hipGetDevice(&dev) != hipSuccess || hipDeviceGetAttribute(&cus, hipDeviceAttributeMultiprocessorCount, dev) != hipSuccess) { grid = -1; return; }
        if (hipFuncSetAttribute((const void*)fwd, hipFuncAttributeMaxDynamicSharedMemorySize, LDS_BYTES) != hipSuccess) { fprintf(stderr, "kernel_launch: hipFuncSetAttribute failed\n"); grid = -1; return; }
        if (hipOccupancyMaxActiveBlocksPerMultiprocessor(&per_cu, (const void*)fwd, NWAVES * 64, LDS_BYTES) != hipSuccess || per_cu < 1) fprintf(stderr, "kernel_launch: occupancy query reports %d\n", per_cu);
        (void)hipGetLastError();
        grid = cus;
    }
    if (grid < 0) return;
    if (hipMemsetAsync((char*)d_ws + WS_CTL, 0, CTL_ZERO_BYTES, stream) != hipSuccess) return;
    Args a{};
    for (int i = 0; i < 24; ++i) a.in[i] = d_in[i];
    a.out = (float*)d_out; a.ws = (unsigned char*)d_ws;
#if MK_PER_PHASE
    for (int p = 0; p < N_PHASES; ++p) { a.ph_lo = p; a.ph_hi = p + 1; hipLaunchKernelGGL(fwd, dim3(grid), dim3(NWAVES * 64), LDS_BYTES, stream, a); }
#else
    a.ph_lo = 0; a.ph_hi = N_PHASES | (((PROBE_MASK >> 5) & 1u) << 8); hipLaunchKernelGGL(fwd, dim3(grid), dim3(NWAVES * 64), LDS_BYTES, stream, a);
#endif
    const hipError_t le = hipPeekAtLastError();
    if (le != hipSuccess) fprintf(stderr, "kernel_launch: launch failed: %s\n", hipGetErrorName(le));
}
```

```cpp
#include <hip/hip_runtime.h>
#include <cstdio>
#include <cstdint>
#ifndef MK_PER_PHASE
#define MK_PER_PHASE 0
#endif
#ifndef PROBE_MASK
#define PROBE_MASK 0x0u
#endif
#ifndef PROBE_VARIANT
#define PROBE_VARIANT 0x0
#endif
namespace pg8 {
#define PG8_LAS __attribute__((address_space(3)))
typedef unsigned short bf16_t;
typedef short bf16x8 __attribute__((ext_vector_type(8)));
typedef float f32x4 __attribute__((ext_vector_type(4)));
typedef unsigned u32x4 __attribute__((ext_vector_type(4)));
constexpr int BM = 256, BK = 64, HALF = 128, HTB = HALF * BK * 2  , STAGE_BYTES = 8 * HTB, NXCD = 8, WGM = 8;

__host__ __device__ __forceinline__ int lds_byte(int r, int c) { const int st = (r >> 4) * 2 + (c >> 5), rr = r & 15, cc = c & 31, ob = rr * 64 + cc * 2; return st * 1024 + (ob ^ (((ob >> 9) & 1) << 5)); }
__host__ __device__ __forceinline__ void stage_rc(int b, int& R, int& C) { const int st = b / 1024, sb = b % 1024, swz = sb ^ (((sb >> 9) & 1) << 5); R = (st >> 1) * 16 + swz / 64; C = (st & 1) * 32 + (swz % 64) / 2; }
__host__ __device__ __forceinline__ int perm32(int rho) { const int n = rho >> 4, i = rho & 15; return 8 * (i >> 2) + 4 * n + (i & 3); }

struct Unit { int pm, pn, z; };
struct Gemm { const bf16_t* A; const bf16_t* Bt; int M, N, K; const int* arow = nullptr; const bf16_t* A2 = nullptr; const bf16_t* Bt2 = nullptr; };

struct StaticOrder {
    int nM, nN, nwg, G, c, reps;
    __host__ __device__ void init(int M, int N, int G_, int c_, int reps_ = 1) { nM = M / BM; nN = N / BM; nwg = nM * nN; G = G_; c = c_; reps = reps_; }
    __host__ __device__ bool next(int i, Unit& u) const {
        if (reps > 1) { const int per = (nwg - c + G - 1) / G; if (i >= per * reps) return false; i %= per; }
        const long L = (long)i * G + c; if (L >= nwg) return false;
        int wgid = (int)L; { const int q = nwg / NXCD, r = nwg % NXCD, xcd = wgid % NXCD, off = wgid / NXCD; wgid = (xcd < r ? xcd * (q + 1) : r * (q + 1) + (xcd - r) * q) + off; }
        const int nig = WGM * nN, gid = wgid / nig, fm = gid * WGM, gsz = (nM - fm) < WGM ? (nM - fm) : WGM;
        u.pm = fm + ((wgid % nig) % gsz); u.pn = (wgid % nig) / gsz; u.z = 0; return true;
    }
    __device__ __forceinline__ void a_ready(const Unit&) const {}
    __device__ __forceinline__ void done(const Unit&) const {}
};

typedef float f32x2 __attribute__((ext_vector_type(2)));
typedef __bf16 bf16x2_c __attribute__((ext_vector_type(2)));
__device__ __forceinline__ unsigned cvt_pk_bf16(float lo, float hi) { f32x2 v = {lo, hi}; bf16x2_c b2 = __builtin_convertvector(v, bf16x2_c); return __builtin_bit_cast(unsigned, b2); }
template <class Epi, class Sched, bool ALIGN_EPI = false, bool SP2 = false, bool GATHER = false>
__device__ __forceinline__ void gemm_phase(PG8_LAS unsigned char* lds, const Gemm g, const Sched& S, const Epi& E) {
    const int tid = threadIdx.x, wid = __builtin_amdgcn_readfirstlane(tid >> 6), lane = tid & 63, wr = wid >> 2, wc = wid & 3, fr = lane & 15, fq = lane >> 4;
    const int K = g.K, nt = K / BK;
    unsigned voffA[2], voffB[2];
#pragma unroll
    for (int i = 0; i < 2; ++i) { int R, C; stage_rc(tid * 16 + i * 8192, R, C); const int Rb = Epi::PERM ? ((R & ~31) + perm32(R & 31)) : R;
        voffA[i] = (unsigned)(R * K + C) * 2u; voffB[i] = (unsigned)(Rb * K + C) * 2u; }
    const size_t kstep = (size_t)(BK * 2);
    const size_t hstep = (size_t)HALF * K * 2;
    const size_t tstep = 2 * hstep;
    const unsigned ldsw = (unsigned)wid * 1024u;
    const int aoff = lds_byte(wr * 64 + fr, fq * 8), boff = lds_byte(wc * 32 + fr, fq * 8);
#define PG8_SA(b, h) (((b) * 2 + (h)) * HTB)
#define PG8_SB(b, h) ((4 + (b) * 2 + (h)) * HTB)
#define PG8_STAGE(bufoff, gbase, voff) do { _Pragma("unroll") for (int _i = 0; _i < 2; ++_i) \
        __builtin_amdgcn_global_load_lds((const unsigned*)((const char*)(gbase) + (voff)[_i]), (PG8_LAS unsigned*)(lds + (bufoff) + ldsw + _i * 8192), 16, 0, 0); } while (0)
#define PG8_LDA(dst, b, h) do { _Pragma("unroll") for (int m = 0; m < 4; ++m) _Pragma("unroll") for (int k = 0; k < 2; ++k) dst[m][k] = *(const PG8_LAS bf16x8*)(lds + PG8_SA(b, h) + aoff + m * 2048 + k * 1024); } while (0)
#define PG8_LDB(dst, b, h) do { _Pragma("unroll") for (int n = 0; n < 2; ++n) _Pragma("unroll") for (int k = 0; k < 2; ++k) dst[n][k] = *(const PG8_LAS bf16x8*)(lds + PG8_SB(b, h) + boff + n * 2048 + k * 1024); } while (0)
#define PG8_MMA(ai, bj, At, Bt) do { __builtin_amdgcn_s_setprio(1); _Pragma("unroll") for (int m = 0; m < 4; ++m) _Pragma("unroll") for (int n = 0; n < 2; ++n) _Pragma("unroll") for (int k = 0; k < 2; ++k) \
        acc[ai][bj][m][n] = __builtin_amdgcn_mfma_f32_16x16x32_bf16(Bt[n][k], At[m][k], acc[ai][bj][m][n], 0, 0, 0); __builtin_amdgcn_s_setprio(0); } while (0)
#define PG8_WAIT_V(n) asm volatile("s_waitcnt vmcnt(" #n ")" ::: "memory")
#define PG8_WAIT_L(n) asm volatile("s_waitcnt lgkmcnt(" #n ")" ::: "memory")
#define PG8_BAR __builtin_amdgcn_s_barrier()
#define PG8_SCHED __builtin_amdgcn_sched_barrier(0)
    Unit cur, nxt; int ui = 0;
    if (!S.next(0, cur)) return;
    static_assert(!GATHER || SP2, "the gathered-A form exists for the SP2 loop only");
    unsigned vc0[2], vc1[2], vn0[2], vn1[2];
#define PG8_GOFFS(u_, o0_, o1_) do { _Pragma("unroll") for (int i = 0; i < 2; ++i) { int R, C; stage_rc(tid * 16 + i * 8192, R, C); \
        if constexpr (GATHER) { o0_[i] = (unsigned)(g.arow[(u_).pm * BM + R] * K + C) * 2u; o1_[i] = (unsigned)(g.arow[(u_).pm * BM + HALF + R] * K + C) * 2u; } \
        else { o0_[i] = voffA[i]; o1_[i] = voffA[i] + (unsigned)hstep; } } } while (0)
    PG8_GOFFS(cur, vc0, vc1);
#pragma unroll
    for (int i = 0; i < 2; ++i) { vn0[i] = vc0[i]; vn1[i] = vc1[i]; }
    f32x4 acc[2][2][4][2];
#pragma unroll
    for (int a = 0; a < 2; ++a)
#pragma unroll
        for (int b = 0; b < 2; ++b)
#pragma unroll
            for (int m = 0; m < 4; ++m)
#pragma unroll
                for (int n = 0; n < 2; ++n) acc[a][b][m][n] = (f32x4){0.f, 0.f, 0.f, 0.f};
    bf16x8 At[4][2], B0[2][2], B1[2][2];
    const char* cA = (const char*)(cur.z ? g.A2 : g.A) + (GATHER ? (size_t)0 : (size_t)cur.pm * tstep); const char* cB = (const char*)(cur.z ? g.Bt2 : g.Bt) + (size_t)cur.pn * tstep;
    S.a_ready(cur);
    if constexpr (SP2) {
        PG8_STAGE(PG8_SB(0, 0), cB, voffB); PG8_STAGE(PG8_SB(0, 1), cB + hstep, voffB); PG8_STAGE(PG8_SA(0, 0), cA, vc0); PG8_STAGE(PG8_SA(0, 1), cA, vc1);
        if (wr == 1) PG8_BAR;
        PG8_WAIT_V(2); PG8_BAR;
        PG8_STAGE(PG8_SB(1, 0), cB + kstep, voffB); PG8_STAGE(PG8_SA(1, 0), cA + kstep, vc0); PG8_STAGE(PG8_SB(1, 1), cB + hstep + kstep, voffB);
        PG8_WAIT_V(6); PG8_BAR;
    } else {
        PG8_STAGE(PG8_SB(0, 0), cB, voffB); PG8_STAGE(PG8_SA(0, 0), cA, voffA); PG8_STAGE(PG8_SB(0, 1), cB + hstep, voffB); PG8_STAGE(PG8_SA(0, 1), cA + hstep, voffA);
        if (wr == 1) PG8_BAR;
        PG8_WAIT_V(4); PG8_BAR;
        PG8_STAGE(PG8_SB(1, 0), cB + kstep, voffB); PG8_STAGE(PG8_SA(1, 0), cA + kstep, voffA); PG8_STAGE(PG8_SB(1, 1), cB + hstep + kstep, voffB);
        PG8_WAIT_V(6); PG8_BAR;
    }
    for (;;) {
        const bool has_next = S.next(ui + 1, nxt);
        const char* nA = has_next ? (const char*)(nxt.z ? g.A2 : g.A) + (GATHER ? (size_t)0 : (size_t)nxt.pm * tstep) : cA; const char* nB = has_next ? (const char*)(nxt.z ? g.Bt2 : g.Bt) + (size_t)nxt.pn * tstep : cB;
        if constexpr (GATHER) { if (has_next) PG8_GOFFS(nxt, vn0, vn1); }
        for (int t = 0; t < nt; t += 2) {
            const bool last = (t == nt - 2);
            const char* a1 = cA + (size_t)(t + 1) * kstep;
            const char* a2 = last ? nA : cA + (size_t)(t + 2) * kstep; const char* b2 = last ? nB : cB + (size_t)(t + 2) * kstep;
            const char* a3 = a2 + kstep; const char* b3 = b2 + kstep;
            if (last && has_next) S.a_ready(nxt);
            if constexpr (SP2) {
            PG8_LDB(B0, 0, 0); PG8_LDB(B1, 0, 1); PG8_SCHED; PG8_LDA(At, 0, 0); PG8_STAGE(PG8_SA(1, 1), a1, vc1);
            PG8_WAIT_V(8); PG8_WAIT_L(0); PG8_BAR; PG8_MMA(0, 0, At, B0); PG8_MMA(0, 1, At, B1); PG8_BAR; PG8_SCHED;
            PG8_LDA(At, 0, 1); PG8_STAGE(PG8_SB(0, 0), b2, voffB); PG8_STAGE(PG8_SB(0, 1), b2 + hstep, voffB); { const unsigned vs_[2] = {last ? vn0[0] : vc0[0], last ? vn0[1] : vc0[1]}; PG8_STAGE(PG8_SA(0, 0), a2, vs_); }
            PG8_WAIT_V(8); PG8_WAIT_L(0); PG8_BAR; PG8_MMA(1, 0, At, B0); PG8_MMA(1, 1, At, B1); PG8_BAR; PG8_SCHED;
            PG8_LDB(B0, 1, 0); PG8_LDB(B1, 1, 1); PG8_SCHED; PG8_LDA(At, 1, 0); { const unsigned vs_[2] = {last ? vn1[0] : vc1[0], last ? vn1[1] : vc1[1]}; PG8_STAGE(PG8_SA(0, 1), a2, vs_); }
            PG8_WAIT_V(8); PG8_WAIT_L(0); PG8_BAR; PG8_MMA(0, 0, At, B0); PG8_MMA(0, 1, At, B1); PG8_BAR; PG8_SCHED;
            PG8_LDA(At, 1, 1); PG8_STAGE(PG8_SB(1, 0), b3, voffB); PG8_STAGE(PG8_SB(1, 1), b3 + hstep, voffB); { const unsigned vs_[2] = {last ? vn0[0] : vc0[0], last ? vn0[1] : vc0[1]}; PG8_STAGE(PG8_SA(1, 0), a3, vs_); }
            PG8_WAIT_V(8); PG8_WAIT_L(0); PG8_BAR; PG8_MMA(1, 0, At, B0); PG8_MMA(1, 1, At, B1); PG8_BAR; PG8_SCHED;
            } else {
            PG8_LDB(B0, 0, 0); PG8_SCHED; PG8_LDA(At, 0, 0); PG8_STAGE(PG8_SA(1, 1), a1 + hstep, voffA);
            PG8_WAIT_L(8); PG8_BAR; PG8_WAIT_L(0); PG8_MMA(0, 0, At, B0); PG8_BAR; PG8_SCHED;
            PG8_LDB(B1, 0, 1); PG8_STAGE(PG8_SB(0, 0), b2, voffB);
            PG8_BAR; PG8_WAIT_L(0); PG8_MMA(0, 1, At, B1); PG8_BAR;
            PG8_LDA(At, 0, 1); PG8_STAGE(PG8_SA(0, 0), a2, voffA);
            PG8_BAR; PG8_WAIT_L(0); PG8_MMA(1, 0, At, B0); PG8_BAR; PG8_SCHED;
            PG8_STAGE(PG8_SB(0, 1), b2 + hstep, voffB);
            PG8_WAIT_V(6); PG8_BAR; PG8_MMA(1, 1, At, B1); PG8_BAR;
            PG8_LDB(B0, 1, 0); PG8_SCHED; PG8_LDA(At, 1, 0); PG8_STAGE(PG8_SA(0, 1), a2 + hstep, voffA);
            PG8_WAIT_L(8); PG8_BAR; PG8_WAIT_L(0); PG8_MMA(0, 0, At, B0); PG8_BAR; PG8_SCHED;
            PG8_LDB(B1, 1, 1); PG8_STAGE(PG8_SB(1, 0), b3, voffB);
            PG8_BAR; PG8_WAIT_L(0); PG8_MMA(0, 1, At, B1); PG8_BAR;
            PG8_LDA(At, 1, 1); PG8_STAGE(PG8_SA(1, 0), a3, voffA);
            PG8_BAR; PG8_WAIT_L(0); PG8_MMA(1, 0, At, B0); PG8_BAR; PG8_SCHED;
            PG8_STAGE(PG8_SB(1, 1), b3 + hstep, voffB);
            PG8_WAIT_V(6); PG8_BAR; PG8_MMA(1, 1, At, B1); PG8_BAR;
            }
        }
        if constexpr (ALIGN_EPI) { if (wr == 0) PG8_BAR; }
        if constexpr (!Epi::AFTER_DRAIN) { E(acc, cur, wr, wc, fr, fq); S.done(cur); }
        if (!has_next) break;
#pragma unroll
        for (int a = 0; a < 2; ++a)
#pragma unroll
            for (int b = 0; b < 2; ++b)
#pragma unroll
                for (int m = 0; m < 4; ++m)
#pragma unroll
                    for (int n = 0; n < 2; ++n) acc[a][b][m][n] = (f32x4){0.f, 0.f, 0.f, 0.f};
        cur = nxt; cA = nA; cB = nB; ++ui;
#pragma unroll
        for (int i = 0; i < 2; ++i) { vc0[i] = vn0[i]; vc1[i] = vn1[i]; }
        if constexpr (ALIGN_EPI) { if (wr == 1) PG8_BAR; }
    }
    PG8_WAIT_V(0);
    if constexpr (!ALIGN_EPI) { if (wr == 0) PG8_BAR; }
    PG8_BAR;
    if constexpr (Epi::AFTER_DRAIN) { E.fused(acc, cur, wr, wc, fr, fq, lds, wid, lane); S.done(cur); }
#undef PG8_SA
#undef PG8_SB
#undef PG8_STAGE
#undef PG8_LDA
#undef PG8_LDB
#undef PG8_MMA
#undef PG8_WAIT_V
#undef PG8_WAIT_L
#undef PG8_BAR
#undef PG8_SCHED
#undef PG8_GOFFS
}
}

#define GAS __attribute__((address_space(1)))
#define LAS __attribute__((address_space(3)))
typedef unsigned short bf16;
typedef unsigned v4u __attribute__((ext_vector_type(4)));
typedef unsigned v2u __attribute__((ext_vector_type(2)));
typedef float f32x4 __attribute__((ext_vector_type(4)));
typedef float f32x2 __attribute__((ext_vector_type(2)));
typedef short bf16x8 __attribute__((ext_vector_type(8)));
typedef GAS unsigned gu32;
#define RLX_AGENT __ATOMIC_RELAXED, __HIP_MEMORY_SCOPE_AGENT
#define LDS_WAIT() asm volatile("s_waitcnt lgkmcnt(0)" ::: "memory")
#define VM_WAIT() asm volatile("s_waitcnt vmcnt(0)" ::: "memory")
__device__ __forceinline__ unsigned f2bf(float f) { unsigned u = __builtin_bit_cast(unsigned, f); return (u + 0x7fffu + ((u >> 16) & 1u)) >> 16; }
typedef __bf16 bf16x2_t __attribute__((ext_vector_type(2)));
__device__ __forceinline__ unsigned cvtpk_c(float lo, float hi) { f32x2 v = {lo, hi}; bf16x2_t b2 = __builtin_convertvector(v, bf16x2_t); return __builtin_bit_cast(unsigned, b2); }
__device__ __forceinline__ unsigned pk2(float lo, float hi) { return cvtpk_c(lo, hi); }
__device__ __forceinline__ float bf2f(unsigned v) { return __builtin_bit_cast(float, v << 16); }
__device__ __forceinline__ float bflo(unsigned w) { return __builtin_bit_cast(float, w << 16); }
__device__ __forceinline__ float bfhi(unsigned w) { return __builtin_bit_cast(float, w & 0xffff0000u); }
__device__ __forceinline__ float sigmoidf_(float x) { return __builtin_amdgcn_rcpf(1.f + __expf(-x)); }
__device__ __forceinline__ float siluf_(float x) { return x * __builtin_amdgcn_rcpf(1.f + __expf(-x)); }
__device__ __forceinline__ float wave_sum(float v) {
#pragma unroll
    for (int o = 1; o < 64; o <<= 1) v += __shfl_xor(v, o);
    return v;
}
#define XB_TMO      128
#define XB_XCNT(j)  (256  + 64 * (j))
#define XB_XSUB(j)  (1280 + 64 * (j))
#define XB_XGEN(j)  (2304 + 64 * (j))
#define XB_TOP      3328
#define XB_TOPGEN   3392
#define XCD_BAR_WORDS 3456
#define XB_SPIN_CAP (1u << 18)

__device__ __forceinline__ unsigned xb_ld(unsigned* p)              { return __hip_atomic_load(p, __ATOMIC_RELAXED, __HIP_MEMORY_SCOPE_AGENT); }
__device__ __forceinline__ unsigned xb_add(unsigned* p, unsigned v) { return __hip_atomic_fetch_add(p, v, __ATOMIC_RELAXED, __HIP_MEMORY_SCOPE_AGENT); }
__device__ __forceinline__ unsigned xb_xcc_id() { return (unsigned)__builtin_amdgcn_s_getreg((3 << 11) | 20) & 0xFu; }
#define XB_SPIN(cond, bar) do { unsigned _sp = 0; while (cond) { __builtin_amdgcn_s_sleep(1); \
    if ((++_sp & 255u) == 0u) { if (xb_ld(&(bar)[XB_TMO])) break; if (_sp > XB_SPIN_CAP) { atomicAdd(&(bar)[XB_TMO], 1u); break; } } } } while (0)

struct XcdBarrier {
    unsigned* bar; unsigned x;
    volatile LAS unsigned* st;
};

__device__ __forceinline__ XcdBarrier xcd_barrier_post(unsigned* bar, volatile LAS unsigned* st) {
    XcdBarrier b; b.bar = bar; b.x = xb_xcc_id(); b.st = st;
    if (threadIdx.x == 0) (void)xb_add(&bar[XB_XCNT(b.x)], 1u);
    return b;
}
__device__ __forceinline__ void xcd_barrier_complete(unsigned* bar, unsigned x, unsigned& nloc, unsigned& nx) {
    const unsigned G = gridDim.x * gridDim.y * gridDim.z;
    unsigned sum, cnt, mine, sp = 0u;
    for (;;) {
        sum = 0u; cnt = 0u; mine = 0u;
#pragma unroll
        for (unsigned j = 0; j < 16; ++j) { const unsigned c = xb_ld(&bar[XB_XCNT(j)]); sum += c; cnt += (c > 0u) ? 1u : 0u; mine = (j == x) ? c : mine; }
        if (sum == G) break;
        __builtin_amdgcn_s_sleep(1);
        if ((++sp & 255u) == 0u) { if (xb_ld(&bar[XB_TMO])) break; if (sp > XB_SPIN_CAP) { atomicAdd(&bar[XB_TMO], 1u); break; } }
    }
    nloc = mine > 0u ? mine : 1u; nx = cnt > 0u ? cnt : 1u;
}

__device__ __forceinline__ void xcd_barrier(const XcdBarrier& b) {
    asm volatile("s_waitcnt vmcnt(0)" ::: "memory");
    __syncthreads();
    if (threadIdx.x == 0) {
        unsigned* bar = b.bar;
        __builtin_amdgcn_s_waitcnt(0);
        unsigned nloc = b.st[0], nx = b.st[1];
        if (nloc == 0u) { xcd_barrier_complete(bar, b.x, nloc, nx); b.st[0] = nloc; b.st[1] = nx; }
        const unsigned old = xb_add(&bar[XB_XSUB(b.x)], 1u);
        const unsigned gen = old / nloc;
        if (old + 1u == (gen + 1u) * nloc) {
            __builtin_amdgcn_fence(__ATOMIC_RELEASE, "agent");
            asm volatile("s_waitcnt vmcnt(0)" ::: "memory");
            const unsigned og = xb_add(&bar[XB_TOP], 1u);
            const unsigned tg = og / nx;
            if (og + 1u == (tg + 1u) * nx) xb_add(&bar[XB_TOPGEN], 1u);
            else XB_SPIN(xb_ld(&bar[XB_TOPGEN]) == tg, bar);
            __builtin_amdgcn_fence(__ATOMIC_ACQUIRE, "agent");
            xb_add(&bar[XB_XGEN(b.x)], 1u);
            asm volatile("s_waitcnt vmcnt(0)" ::: "memory");
        } else {
            XB_SPIN(xb_ld(&bar[XB_XGEN(b.x)]) == gen, bar);
            __builtin_amdgcn_fence(__ATOMIC_ACQUIRE, "agent");
            asm volatile("s_waitcnt vmcnt(0)" ::: "memory");
        }
    }
    __syncthreads();
}

constexpr int NB = 4, SEQ = 4096, DM = 1024, NTOK = NB * SEQ;
constexpr int DNH = 8, DHD = 128;
constexpr int MH = 8, QL = 512, KVL = 256, QKD = 192, NOPE = 128;
constexpr int NE = 16, CAP = 512;
constexpr int NPROJ = 7168;
constexpr float EPS = 1e-6f;
constexpr float QSCALE = 0.07216878364870322f * 1.4426950408889634f;
constexpr int NWAVES = 8;

constexpr size_t MiB = 1u << 20;
constexpr size_t WS_CTL = 0, CTL_ZERO_BYTES = 32 * 1024;
constexpr size_t WS_MOD = 1 * MiB;
constexpr size_t WS_IDX = 1 * MiB + 256 * 1024;
constexpr size_t WS_GATEW = 1 * MiB + 512 * 1024;
constexpr size_t WS_ZROW = 1 * MiB + 768 * 1024;
constexpr size_t WS_CS = 2 * MiB;
constexpr size_t WS_BETA = 6 * MiB;
constexpr size_t WS_G = 7 * MiB;
constexpr size_t WS_SSQQ = 8 * MiB;
constexpr size_t WS_SSQKV = 8 * MiB + 512 * 1024;
constexpr size_t WS_KROPE = 9 * MiB;
constexpr size_t WS_GC = 11 * MiB;
constexpr size_t WS_AFF = 12 * MiB;
constexpr size_t WS_SLOT = 13 * MiB;
constexpr size_t WS_WODN = 14 * MiB, WS_WOMLA = 16 * MiB, WS_WOUT = 18 * MiB;
constexpr size_t WS_WIN = 20 * MiB;
constexpr size_t WS_WUQ = 34 * MiB;
constexpr size_t WS_WUKV = 35 * MiB + 512 * 1024;
constexpr size_t WS_ODIR = 20 * MiB;
constexpr size_t WS_A = 37 * MiB;
constexpr size_t WS_QKV = 85 * MiB;
constexpr size_t WS_XE = 85 * MiB, WS_YE = 85 * MiB;
constexpr size_t WS_HID = 149 * MiB;
constexpr size_t WS_Z = 181 * MiB;
constexpr size_t WS_GATES = 213 * MiB;
constexpr size_t WS_WGU = 213 * MiB;
constexpr size_t WS_CQ = 277 * MiB;
constexpr size_t WS_CKV = 293 * MiB;
constexpr size_t WS_OMLA = 277 * MiB;
constexpr size_t WS_WD = 277 * MiB;
constexpr size_t WS_HALO = 309 * MiB;
constexpr size_t WS_CB = 315 * MiB;
constexpr size_t WS_BT = 316 * MiB;
constexpr size_t WS_X1A = 20 * MiB;
constexpr size_t WS_X1B = 69 * MiB;
constexpr size_t WS_END = 317 * MiB;
constexpr int CW_TMO = 0, CW_CODE = 1, CW_BAR = 4096;

constexpr int RING_BYTES = 131072;
constexpr int LDSCTL_OFF = 155648, MISC_OFF = LDSCTL_OFF + 320;
constexpr int LDS_BYTES = 156672;

typedef pg8::Unit Unit;
typedef const f32x4 (&AccRef)[2][2][4][2];
__device__ __forceinline__ v4u pack8(const f32x4 a, const f32x4 b) { v4u w; w.x = pg8::cvt_pk_bf16(a[0], a[1]); w.y = pg8::cvt_pk_bf16(a[2], a[3]); w.z = pg8::cvt_pk_bf16(b[0], b[1]); w.w = pg8::cvt_pk_bf16(b[2], b[3]); return w; }
__device__ __forceinline__ float softplusf_(float x) { return fmaxf(x, 0.f) + log1pf(__expf(-fabsf(x))); }

__device__ __forceinline__ void rope8(f32x4& a, f32x4& b, const float* csrow) {
    const f32x4 c0 = *(const f32x4*)(csrow), c1 = *(const f32x4*)(csrow + 4);
    f32x4 oa, ob;
    oa[0] = a[0] * c0[0] - a[1] * c0[1]; oa[1] = a[1] * c0[0] + a[0] * c0[1];
    oa[2] = a[2] * c0[2] - a[3] * c0[3]; oa[3] = a[3] * c0[2] + a[2] * c0[3];
    ob[0] = b[0] * c1[0] - b[1] * c1[1]; ob[1] = b[1] * c1[0] + b[0] * c1[1];
    ob[2] = b[2] * c1[2] - b[3] * c1[3]; ob[3] = b[3] * c1[2] + b[2] * c1[3];
    a = oa; b = ob;
}

struct EpiProj {
    static constexpr bool PERM = true, AFTER_DRAIN = false;
    bf16 *qkv, *z, *gates, *cq, *ckv, *halo, *krope; float *ssq_q, *ssq_kv, *beta, *g; const float *cs, *a_log, *dt_bias;
    __device__ __forceinline__ void operator()(AccRef acc, const Unit& u, int wr, int wc, int fr, int fq) const {
        const int pn = u.pn, rbase = u.pm * 256 + wr * 64 + fr, cin = wc * 32 + 8 * fq;
        if (pn < 12) {
#pragma unroll
            for (int ai = 0; ai < 2; ++ai)
#pragma unroll
                for (int m = 0; m < 4; ++m) { const int row = rbase + ai * 128 + m * 16, t64 = row & 63;
                    const bool hl = (t64 < 2) || (t64 >= 62); const int hidx = (row >> 6) * 4 + (t64 < 2 ? t64 : t64 - 60);
#pragma unroll
                    for (int bj = 0; bj < 2; ++bj) { const int col = pn * 256 + bj * 128 + cin; const v4u w = pack8(acc[ai][bj][m][0], acc[ai][bj][m][1]);
                        *(v4u*)(qkv + (size_t)row * 3072 + col) = w; if (hl) *(v4u*)(halo + (size_t)hidx * 3072 + col) = w; } }
        } else if (pn < 16) {
#pragma unroll
            for (int ai = 0; ai < 2; ++ai)
#pragma unroll
                for (int m = 0; m < 4; ++m) { const int row = rbase + ai * 128 + m * 16;
#pragma unroll
                    for (int bj = 0; bj < 2; ++bj) { const int col = (pn - 12) * 256 + bj * 128 + cin; *(v4u*)(z + (size_t)row * 1024 + col) = pack8(acc[ai][bj][m][0], acc[ai][bj][m][1]); } }
        } else if (pn < 24) {
#pragma unroll
            for (int ai = 0; ai < 2; ++ai)
#pragma unroll
                for (int m = 0; m < 4; ++m) { const int row = rbase + ai * 128 + m * 16;
#pragma unroll
                    for (int bj = 0; bj < 2; ++bj) { const int col = (pn - 16) * 256 + bj * 128 + cin; f32x4 a = acc[ai][bj][m][0], b = acc[ai][bj][m][1];
#pragma unroll
                        for (int e = 0; e < 4; ++e) { a[e] = sigmoidf_(a[e]); b[e] = sigmoidf_(b[e]); }
                        *(v4u*)(gates + (size_t)row * 2048 + col) = pack8(a, b); } }
        } else if (pn < 27) {
            const bool isq = pn < 26; bf16* dst = isq ? cq : ckv; const int pitch = isq ? 512 : 256, cb = isq ? (pn - 24) * 256 : 0;
#pragma unroll
            for (int ai = 0; ai < 2; ++ai)
#pragma unroll
                for (int m = 0; m < 4; ++m) { const int row = rbase + ai * 128 + m * 16; float s = 0.f;
#pragma unroll
                    for (int bj = 0; bj < 2; ++bj) { const f32x4 a = acc[ai][bj][m][0], b = acc[ai][bj][m][1];
                        s += (a[0] * a[0] + a[1] * a[1]) + (a[2] * a[2] + a[3] * a[3]) + (b[0] * b[0] + b[1] * b[1]) + (b[2] * b[2] + b[3] * b[3]);
                        *(v4u*)(dst + (size_t)row * pitch + cb + bj * 128 + cin) = pack8(a, b); }
                    s += __shfl_xor(s, 16); s += __shfl_xor(s, 32);
                    if (fq == 0) { if (isq) ssq_q[row * 8 + (pn - 24) * 4 + wc] = s; else ssq_kv[row * 4 + wc] = s; } }
        } else {
#pragma unroll
            for (int ai = 0; ai < 2; ++ai)
#pragma unroll
                for (int m = 0; m < 4; ++m) { const int row = rbase + ai * 128 + m * 16; f32x4 a = acc[ai][0][m][0], b = acc[ai][0][m][1];
                    if (wc < 2) { rope8(a, b, cs + ((size_t)row * 32 + cin / 2) * 2); *(v4u*)(krope + (size_t)row * 64 + cin) = pack8(a, b); }
                    else if (wc == 2) {
                        if (fq < 2) { f32x4 oa, ob;
#pragma unroll
                            for (int e = 0; e < 4; ++e) { oa[e] = sigmoidf_(a[e]); ob[e] = sigmoidf_(b[e]); }
                            *(f32x4*)(beta + (size_t)row * 16 + 8 * fq) = oa; *(f32x4*)(beta + (size_t)row * 16 + 8 * fq + 4) = ob; }
                        else { const int j0 = 8 * (fq - 2); f32x4 oa, ob;
#pragma unroll
                            for (int e = 0; e < 4; ++e) { oa[e] = -__expf(a_log[j0 + e]) * softplusf_(a[e] + dt_bias[j0 + e]); ob[e] = -__expf(a_log[j0 + 4 + e]) * softplusf_(b[e] + dt_bias[j0 + 4 + e]); }
                            *(f32x4*)(g + (size_t)row * 16 + j0) = oa; *(f32x4*)(g + (size_t)row * 16 + j0 + 4) = ob; } } }
        }
    }
};

struct EpiQ {
    static constexpr bool PERM = true, AFTER_DRAIN = false;
    bf16* q; const float *ssq, *cs;
    __device__ __forceinline__ void operator()(AccRef acc, const Unit& u, int wr, int wc, int fr, int fq) const {
        const int rbase = u.pm * 256 + wr * 64 + fr, cin = wc * 32 + 8 * fq;
#pragma unroll
        for (int ai = 0; ai < 2; ++ai)
#pragma unroll
            for (int m = 0; m < 4; ++m) { const int row = rbase + ai * 128 + m * 16;
                const f32x4 s0 = *(const f32x4*)(ssq + (size_t)row * 8), s1 = *(const f32x4*)(ssq + (size_t)row * 8 + 4);
                const float r = rsqrtf(((s0[0] + s0[1]) + (s0[2] + s0[3]) + (s1[0] + s1[1]) + (s1[2] + s1[3])) * (1.f / QL) + EPS) * QSCALE;
#pragma unroll
                for (int bj = 0; bj < 2; ++bj) { const int col = u.pn * 256 + bj * 128 + cin, off = col % QKD; f32x4 a = acc[ai][bj][m][0] * r, b = acc[ai][bj][m][1] * r;
                    if (off >= NOPE) rope8(a, b, cs + ((size_t)row * 32 + (off - NOPE) / 2) * 2);
                    *(v4u*)(q + (size_t)row * 1536 + col) = pack8(a, b); } }
    }
};
struct EpiKV {
    static constexpr bool PERM = true, AFTER_DRAIN = false;
    bf16* kv; const float* ssq;
    __device__ __forceinline__ void operator()(AccRef acc, const Unit& u, int wr, int wc, int fr, int fq) const {
        const int rbase = u.pm * 256 + wr * 64 + fr, cin = wc * 32 + 8 * fq;
#pragma unroll
        for (int ai = 0; ai < 2; ++ai)
#pragma unroll
            for (int m = 0; m < 4; ++m) { const int row = rbase + ai * 128 + m * 16;
                const f32x4 s0 = *(const f32x4*)(ssq + (size_t)row * 4);
                const float r = rsqrtf(((s0[0] + s0[1]) + (s0[2] + s0[3])) * (1.f / KVL) + EPS);
#pragma unroll
                for (int bj = 0; bj < 2; ++bj) { const int col = u.pn * 256 + bj * 128 + cin;
                    *(v4u*)(kv + (size_t)row * 2048 + col) = pack8(acc[ai][bj][m][0] * r, acc[ai][bj][m][1] * r); } }
    }
};
__device__ __forceinline__ void unpack8(const v4u w, f32x4& a, f32x4& b) { a[0] = bflo(w.x); a[1] = bfhi(w.x); a[2] = bflo(w.y); a[3] = bfhi(w.y); b[0] = bflo(w.z); b[1] = bfhi(w.z); b[2] = bflo(w.w); b[3] = bfhi(w.w); }
template <int MODE>
struct EpiMix {
    static constexpr bool PERM = true, AFTER_DRAIN = false;
    bf16* y; const bf16* gates;
    __device__ __forceinline__ void operator()(AccRef acc, const Unit& u, int wr, int wc, int fr, int fq) const {
        const int rbase = u.pm * 256 + wr * 64 + fr, cin = wc * 32 + 8 * fq;
#pragma unroll
        for (int bj = 0; bj < 2; ++bj) { const int col = u.pn * 256 + bj * 128 + cin;
#pragma unroll
            for (int ai = 0; ai < 2; ++ai) { v4u gv[4], yv[4];
#pragma unroll
                for (int m = 0; m < 4; ++m) { const int row = rbase + ai * 128 + m * 16; gv[m] = *(const v4u*)(gates + (size_t)row * 2048 + MODE * 1024 + col);
                    if (MODE == 1) yv[m] = *(const v4u*)(y + (size_t)row * 1024 + col); }
                asm volatile("" ::: "memory");
#pragma unroll
                for (int m = 0; m < 4; ++m) { const int row = rbase + ai * 128 + m * 16;
                    f32x4 ga, gb; unpack8(gv[m], ga, gb);
                    f32x4 a = acc[ai][bj][m][0] * ga, b = acc[ai][bj][m][1] * gb;
                    if (MODE == 1) { f32x4 ya, yb; unpack8(yv[m], ya, yb); a = a + ya; b = b + yb; }
                    *(v4u*)(y + (size_t)row * 1024 + col) = pack8(a, b); }
                asm volatile("" ::: "memory"); }
        }
    }
};
struct EpiOut {
    static constexpr bool PERM = true, AFTER_DRAIN = false;
    unsigned char* ws; const float *x, *mod;
    __device__ __forceinline__ void operator()(AccRef acc, const Unit& u, int wr, int wc, int fr, int fq) const {
        const int rbase = u.pm * 256 + wr * 64 + fr, cin = wc * 32 + 8 * fq; const int b = (u.pm * 256) / SEQ;
        bf16* x1 = (u.pm < 32) ? (bf16*)(ws + WS_X1A) : (bf16*)(ws + WS_X1B) - (size_t)8192 * 1024;
#pragma unroll
        for (int bj = 0; bj < 2; ++bj) { const int col = u.pn * 256 + bj * 128 + cin;
            const f32x4 g0 = *(const f32x4*)(mod + b * 6144 + 2048 + col), g1 = *(const f32x4*)(mod + b * 6144 + 2048 + col + 4);
#pragma unroll
            for (int ai = 0; ai < 2; ++ai) { f32x4 xv[4][2];
#pragma unroll
                for (int m = 0; m < 4; ++m) { const size_t o = (size_t)(rbase + ai * 128 + m * 16) * 1024 + col; xv[m][0] = *(const f32x4*)(x + o); xv[m][1] = *(const f32x4*)(x + o + 4); }
                asm volatile("" ::: "memory");
#pragma unroll
                for (int m = 0; m < 4; ++m) { const size_t o = (size_t)(rbase + ai * 128 + m * 16) * 1024 + col;
                    *(v4u*)(x1 + o) = pack8(xv[m][0] + g0 * acc[ai][bj][m][0], xv[m][1] + g1 * acc[ai][bj][m][1]); }
                asm volatile("" ::: "memory"); } }
    }
};
struct EpiGU {
    static constexpr bool PERM = true, AFTER_DRAIN = false;
    bf16* hid;
    __device__ __forceinline__ void operator()(AccRef acc, const Unit& u, int wr, int wc, int fr, int fq) const {
        const int rbase = u.pm * 256 + wr * 64 + fr, cin = wc * 32 + 8 * fq;
#pragma unroll
        for (int ai = 0; ai < 2; ++ai)
#pragma unroll
            for (int m = 0; m < 4; ++m) { const int row = rbase + ai * 128 + m * 16;
#pragma unroll
                for (int bj = 0; bj < 2; ++bj) { const int hc = ((u.pn & 7) * 256 + bj * 128 + cin) >> 1; const f32x4 gt = acc[ai][bj][m][0], up = acc[ai][bj][m][1];
                    v2u w; w.x = pg8::cvt_pk_bf16(siluf_(gt[0]) * up[0], siluf_(gt[1]) * up[1]); w.y = pg8::cvt_pk_bf16(siluf_(gt[2]) * up[2], siluf_(gt[3]) * up[3]);
                    *(v2u*)(hid + (size_t)row * 1024 + hc) = w; } }
    }
};
struct EpiDown {
    static constexpr bool PERM = true, AFTER_DRAIN = false;
    bf16* ye; const float* gatew;
    __device__ __forceinline__ void operator()(AccRef acc, const Unit& u, int wr, int wc, int fr, int fq) const {
        const int rbase = u.pm * 256 + wr * 64 + fr, cin = wc * 32 + 8 * fq;
        float gws[2][4];
#pragma unroll
        for (int ai = 0; ai < 2; ++ai)
#pragma unroll
            for (int m = 0; m < 4; ++m) gws[ai][m] = gatew[rbase + ai * 128 + m * 16];
        asm volatile("" ::: "memory");
#pragma unroll
        for (int ai = 0; ai < 2; ++ai)
#pragma unroll
            for (int m = 0; m < 4; ++m) { const int row = rbase + ai * 128 + m * 16; const float gw = gws[ai][m];
#pragma unroll
                for (int bj = 0; bj < 2; ++bj) { const int col = (u.pn & 3) * 256 + bj * 128 + cin;
                    *(v4u*)(ye + (size_t)row * 1024 + col) = pack8(acc[ai][bj][m][0] * gw, acc[ai][bj][m][1] * gw); } }
    }
};
struct MoeOrder {
    int nwg, G, c, ntn, reps;
    __device__ void init(int ntn_, int G_, int c_, int reps_ = 1) { ntn = ntn_; nwg = 64 * 2 * ntn_; G = G_; c = c_; reps = reps_; }
    __device__ bool next(int i, Unit& u) const { if (reps > 1) { const int per = (nwg - c + G - 1) / G; if (i >= per * reps) return false; i %= per; }
        const int L = i * G + c; if (L >= nwg) return false;
        int nt, mh, be;
        if (G == 256) {
            const int x = c & 7, j = c >> 3, per_round = 128 / ntn;
            nt = j % ntn; mh = (j / ntn) & 1; be = i * per_round + (j / (2 * ntn)) * 8 + x;
        } else { nt = L % ntn; mh = (L / ntn) & 1; be = L / (2 * ntn); }
        u.pm = be * 2 + mh; u.pn = (be & 15) * ntn + nt; u.z = 0; return true; }
    __device__ __forceinline__ void a_ready(const Unit&) const {}
    __device__ __forceinline__ void done(const Unit&) const {}
};

struct KvOrder {
    int G, c, reps;
    __device__ void init(int G_, int c_, int reps_ = 1) { G = G_; c = c_; reps = reps_; }
    __device__ bool next(int i, Unit& u) const { int L;
        if (G == 256) { const int per = (c < 128) ? 1 : 3; if (i >= per * reps) return false; i %= per; L = (c < 128) ? c : 128 + (c - 128) * 3 + i; }
        else { const int per = (512 - c + G - 1) / G; if (i >= per * reps) return false; i %= per; L = i * G + c; }
        u.pm = L >> 3; u.pn = L & 7; u.z = 0; return true; }
    __device__ __forceinline__ void a_ready(const Unit&) const {}
    __device__ __forceinline__ void done(const Unit&) const {}
};

struct EpiMixZ {
    static constexpr bool PERM = true, AFTER_DRAIN = false;
    bf16* y; const bf16* gates;
    __device__ __forceinline__ void operator()(AccRef acc, const Unit& u, int wr, int wc, int fr, int fq) const {
        if (u.z == 0) { EpiMix<0> E{y, gates}; E(acc, u, wr, wc, fr, fq); } else { EpiMix<1> E{y, gates}; E(acc, u, wr, wc, fr, fq); }
    }
};
struct PairOrder {
    pg8::StaticOrder S; int reps;
    __device__ void init(int M, int N, int G_, int c_, int reps_ = 1) { S.init(M, N, G_, c_); reps = reps_; }
    __device__ bool next(int i, Unit& u) const { const int per = (S.nwg - S.c + S.G - 1) / S.G; if (i >= 2 * per * reps) return false; i %= 2 * per; const bool ok = S.next(i >> 1, u); u.z = i & 1; return ok; }
    __device__ __forceinline__ void a_ready(const Unit&) const {}
    __device__ __forceinline__ void done(const Unit&) const {}
};

namespace att {
using bf16x8 = __attribute__((ext_vector_type(8))) short;
using s16x4  = __attribute__((ext_vector_type(4))) short;
using f32x16 = __attribute__((ext_vector_type(16))) float;
using u32x4  = __attribute__((ext_vector_type(4))) unsigned;
constexpr int KVBLK = 64;
constexpr int SHM_V = 16384, SHM_KN = 16384, SHM_KR = 8192;
constexpr int OFF_V = 0, OFF_KN = 2 * SHM_V, OFF_KR = OFF_KN + 2 * SHM_KN, OFF_WS = OFF_KR + 2 * SHM_KR, OFF_QR = OFF_WS + 8 * 64 * 4, ATT_LDS = OFF_QR + 8 * 4096;
constexpr float THR2 = 8.f * 1.4426950408889634f;
#define KSWZ(row, colB) ((row) * 256 + ((colB) ^ (((row) & 7) << 4)))
#define KRSWZ(row, colB) ((row) * 128 + ((colB) ^ ((((row) >> 1) & 7) << 4)))
#define SBAR() __builtin_amdgcn_sched_barrier(0)
__device__ __forceinline__ int crow(int r, int hi) { return (r & 3) + 8 * (r >> 2) + 4 * hi; }
__device__ __forceinline__ unsigned cvtpk(float lo, float hi) { return cvtpk_c(lo, hi); }
__device__ __forceinline__ void partialSM(f32x16& p0, f32x16& p1, float& m_reg, float& mn, float& alpha) {
  float pmax = p0[0];
#pragma unroll
  for (int r = 1; r < 16; ++r) pmax = fmaxf(pmax, p0[r]);
#pragma unroll
  for (int r = 0; r < 16; ++r) pmax = fmaxf(pmax, p1[r]);
  { auto rr = __builtin_amdgcn_permlane32_swap(__float_as_uint(pmax), __float_as_uint(pmax), false, false);
    pmax = fmaxf(__uint_as_float(rr[0]), __uint_as_float(rr[1])); }
  if (__builtin_expect(__all(pmax - m_reg <= THR2), 1)) { mn = m_reg; alpha = 1.f; }
  else { mn = fmaxf(m_reg, pmax); alpha = __builtin_amdgcn_exp2f(m_reg - mn); m_reg = mn; }
#pragma unroll
  for (int r = 0; r < 16; ++r) p0[r] = p0[r] - mn;
#pragma unroll
  for (int r = 0; r < 16; ++r) p1[r] = p1[r] - mn;
#pragma unroll
  for (int r = 0; r < 16; ++r) p0[r] = __builtin_amdgcn_exp2f(p0[r]);
}
__device__ __forceinline__ void finishSM(f32x16& p0, f32x16& p1, float alpha, float& l_reg, bf16x8& pa0, bf16x8& pa1, bf16x8& pa2, bf16x8& pa3) {
#pragma unroll
  for (int r = 0; r < 16; ++r) p1[r] = __builtin_amdgcn_exp2f(p1[r]);
  float ps = 0;
#pragma unroll
  for (int r = 0; r < 16; ++r) ps += p0[r];
#pragma unroll
  for (int r = 0; r < 16; ++r) ps += p1[r];
  { auto rr = __builtin_amdgcn_permlane32_swap(__float_as_uint(ps), __float_as_uint(ps), false, false);
    ps = __uint_as_float(rr[0]) + __uint_as_float(rr[1]); }
  l_reg = l_reg * alpha + ps;
#define PK4(P, BASE, OUT) do { unsigned a0 = cvtpk(P[BASE + 0], P[BASE + 1]), a1 = cvtpk(P[BASE + 2], P[BASE + 3]);   \
    unsigned b0 = cvtpk(P[BASE + 4], P[BASE + 5]), b1 = cvtpk(P[BASE + 6], P[BASE + 7]);                              \
    auto r0 = __builtin_amdgcn_permlane32_swap(a0, b0, false, false); auto r1 = __builtin_amdgcn_permlane32_swap(a1, b1, false, false); \
    u32x4 w = {r0[0], r1[0], r0[1], r1[1]}; OUT = __builtin_bit_cast(bf16x8, w); } while (0)
  PK4(p0, 0, pa0); PK4(p0, 8, pa1); PK4(p1, 0, pa2); PK4(p1, 8, pa3);
#undef PK4
}
__device__ __forceinline__ void qkt(f32x16& p0, f32x16& p1, const char* Kn, const char* Kr, const bf16x8* qr, const char* qrl, int r32, int hi) {
  p0 = f32x16{}; p1 = f32x16{};
#pragma unroll
  for (int d0 = 0; d0 < 8; ++d0) { const int cb = (d0 * 16 + hi * 8) * 2;
    bf16x8 b0 = *reinterpret_cast<const bf16x8*>(Kn + KSWZ(r32, cb));
    bf16x8 b1 = *reinterpret_cast<const bf16x8*>(Kn + KSWZ(32 + r32, cb));
    p0 = __builtin_amdgcn_mfma_f32_32x32x16_bf16(b0, qr[d0], p0, 0, 0, 0);
    p1 = __builtin_amdgcn_mfma_f32_32x32x16_bf16(b1, qr[d0], p1, 0, 0, 0); }
#pragma unroll
  for (int d0 = 0; d0 < 4; ++d0) { const int cb = (d0 * 16 + hi * 8) * 2;
    bf16x8 b0 = *reinterpret_cast<const bf16x8*>(Kr + KRSWZ(r32, cb));
    bf16x8 b1 = *reinterpret_cast<const bf16x8*>(Kr + KRSWZ(32 + r32, cb));
    const bf16x8 qf = *reinterpret_cast<const bf16x8*>(qrl + d0 * 1024);
    p0 = __builtin_amdgcn_mfma_f32_32x32x16_bf16(b0, qf, p0, 0, 0, 0);
    p1 = __builtin_amdgcn_mfma_f32_32x32x16_bf16(b1, qf, p1, 0, 0, 0); }
}
__device__ __forceinline__ int v_st(int k, int c) { const int kk = (k & ~0xC) | ((k & 4) << 1) | ((k & 8) >> 1); return ((kk >> 3) * 4 + (c >> 5)) * 512 + ((kk & 7) * 32 + (c & 31)) * 2; }
__device__ __forceinline__ int v_rd_base(int lane) { return ((lane & 3) << 3) | (((lane >> 2) & 3) << 6) | (((lane >> 4) & 1) << 5) | (((lane >> 5) & 1) << 8); }
constexpr int v_rd_off(int d0, int ks, int half) { return d0 * 512 + ks * 4096 + half * 2048; }
template <int OFF> __device__ __forceinline__ s16x4 tr_read(int vb) {
  s16x4 r; asm volatile("ds_read_b64_tr_b16 %0, %1 offset:%2" : "=&v"(r) : "v"(vb), "i"(OFF) : "memory"); return r;
}
template <int D0> __device__ __forceinline__ void pv_one(f32x16& od, int vb, bf16x8 pa0, bf16x8 pa1, bf16x8 pa2, bf16x8 pa3) {
  const s16x4 l0 = tr_read<v_rd_off(D0, 0, 0)>(vb), h0 = tr_read<v_rd_off(D0, 0, 1)>(vb), l1 = tr_read<v_rd_off(D0, 1, 0)>(vb), h1 = tr_read<v_rd_off(D0, 1, 1)>(vb);
  const s16x4 l2 = tr_read<v_rd_off(D0, 2, 0)>(vb), h2 = tr_read<v_rd_off(D0, 2, 1)>(vb), l3 = tr_read<v_rd_off(D0, 3, 0)>(vb), h3 = tr_read<v_rd_off(D0, 3, 1)>(vb);
  asm volatile("s_waitcnt lgkmcnt(0)" ::: "memory"); SBAR();
#define PK(L, H) (bf16x8){L[0], L[1], L[2], L[3], H[0], H[1], H[2], H[3]}
  od = __builtin_amdgcn_mfma_f32_32x32x16_bf16(pa0, PK(l0, h0), od, 0, 0, 0);
  od = __builtin_amdgcn_mfma_f32_32x32x16_bf16(pa1, PK(l1, h1), od, 0, 0, 0);
  od = __builtin_amdgcn_mfma_f32_32x32x16_bf16(pa2, PK(l2, h2), od, 0, 0, 0);
  od = __builtin_amdgcn_mfma_f32_32x32x16_bf16(pa3, PK(l3, h3), od, 0, 0, 0);
#undef PK
}
__device__ __forceinline__ void pv_d0(f32x16* o, int vb, bf16x8 pa0, bf16x8 pa1, bf16x8 pa2, bf16x8 pa3) {
  pv_one<0>(o[0], vb, pa0, pa1, pa2, pa3); pv_one<1>(o[1], vb, pa0, pa1, pa2, pa3); pv_one<2>(o[2], vb, pa0, pa1, pa2, pa3); pv_one<3>(o[3], vb, pa0, pa1, pa2, pa3);
}
__device__ __forceinline__ void attn_unit(const unsigned short* __restrict__ Qb, const unsigned short* __restrict__ Kn, const unsigned short* __restrict__ Vh, const unsigned short* __restrict__ Kr,
                                          unsigned short* __restrict__ Ob, int seq, char* lds, bool dry = false) {
#ifndef PROBE_VARIANT
#define PROBE_VARIANT 0
#endif
#define PVA(bit) (dry && ((PROBE_VARIANT >> (bit)) & 1))
  const int tid = threadIdx.x, wid = tid >> 6, lane = tid & 63, r32 = lane & 31, hi = lane >> 5;
  char* V_lds = lds + OFF_V; char* KN_lds = lds + OFF_KN; char* KR_lds = lds + OFF_KR;
  float* ws = (float*)(lds + OFF_WS) + wid * 64; float* li_l = ws; float* al_l = ws + 32;
  float m_reg = -1e30f, l_reg = 0; f32x16 o[4] = {}; bf16x8 qr[8];
  const unsigned short* Qw = Qb + (long)(wid * 32 + r32) * 1536 + hi * 8;
  char* qrl = lds + OFF_QR + wid * 4096 + lane * 16;
#pragma unroll
  for (int d0 = 0; d0 < 8; ++d0) qr[d0] = *reinterpret_cast<const bf16x8*>(Qw + d0 * 16);
#pragma unroll
  for (int d0 = 0; d0 < 4; ++d0) *reinterpret_cast<bf16x8*>(qrl + d0 * 1024) = *reinterpret_cast<const bf16x8*>(Qw + (8 + d0) * 16);
  const int sr = tid >> 4, sc = (tid & 15) * 8, vst0 = v_st(sr, sc), vst1 = v_st(32 + sr, sc);
  const int rr_ = tid >> 3, rc_ = (tid & 7) * 8;
  const int vb0 = (int)(uintptr_t)V_lds + v_rd_base(lane);
  bf16x8 vs0, vs1, ks0, ks1, kr0;
  const unsigned kvoff = (unsigned)(sr * 2048 + sc) * 2u, kroff = (unsigned)(rr_ * 64 + rc_) * 2u;
#define SLOAD(k0) do { const char* kb_ = (const char*)Kn + (size_t)(k0) * 4096; const char* vb_ = (const char*)Vh + (size_t)(k0) * 4096; const char* rb_ = (const char*)Kr + (size_t)(k0) * 128; \
    vs0 = *reinterpret_cast<const bf16x8*>(vb_ + kvoff); vs1 = *reinterpret_cast<const bf16x8*>(vb_ + 131072 + kvoff); \
    ks0 = *reinterpret_cast<const bf16x8*>(kb_ + kvoff); ks1 = *reinterpret_cast<const bf16x8*>(kb_ + 131072 + kvoff); \
    kr0 = *reinterpret_cast<const bf16x8*>(rb_ + kroff); } while (0)
#define SWRITE(b) do { *(bf16x8*)(V_lds + (b) * SHM_V + vst0) = vs0; *(bf16x8*)(V_lds + (b) * SHM_V + vst1) = vs1; const int kc = sc * 2; \
    *(bf16x8*)(KN_lds + (b) * SHM_KN + KSWZ(sr, kc)) = ks0; *(bf16x8*)(KN_lds + (b) * SHM_KN + KSWZ(32 + sr, kc)) = ks1; \
    *(bf16x8*)(KR_lds + (b) * SHM_KR + KRSWZ(rr_, rc_ * 2)) = kr0; } while (0)
#define SWAIT() asm volatile("s_waitcnt vmcnt(0)" ::: "memory")
#define RESC(a) do { if (__any((a) < 1.f)) { if (hi == 0) al_l[r32] = (a); asm volatile("s_waitcnt lgkmcnt(0)" ::: "memory"); \
    _Pragma("unroll") for (int d = 0; d < 4; ++d) _Pragma("unroll") for (int r = 0; r < 16; ++r) o[d][r] *= al_l[crow(r, hi)]; } } while (0)
  f32x16 pA0, pA1, pB0, pB1; float mnA, mnB, alA, alB; bf16x8 pa0, pa1, pa2, pa3; const int NT = seq / KVBLK;
  SLOAD(0); SWAIT(); SWRITE(0); __syncthreads();
  qkt(pA0, pA1, KN_lds, KR_lds, qr, qrl, r32, hi); partialSM(pA0, pA1, m_reg, mnA, alA);
  SLOAD(KVBLK); SWAIT(); SWRITE(1); __syncthreads();
  for (int j = 1; j + 1 < NT; j += 2) {
    SBAR(); qkt(pB0, pB1, KN_lds + SHM_KN, KR_lds + SHM_KR, qr, qrl, r32, hi);
    if (!PVA(13)) finishSM(pA0, pA1, alA, l_reg, pa0, pa1, pa2, pa3); SBAR();
    if (!PVA(12)) SLOAD((j + 1) * KVBLK); SBAR();
    pv_d0(o, vb0, pa0, pa1, pa2, pa3); if (!PVA(13)) partialSM(pB0, pB1, m_reg, mnB, alB);
    if (!PVA(14)) __syncthreads(); if (!PVA(12)) { SWAIT(); SWRITE(0); }
    RESC(alB); if (!PVA(14)) __syncthreads();
    SBAR(); qkt(pA0, pA1, KN_lds, KR_lds, qr, qrl, r32, hi);
    if (!PVA(13)) finishSM(pB0, pB1, alB, l_reg, pa0, pa1, pa2, pa3); SBAR();
    if (!PVA(12)) SLOAD((j + 2) * KVBLK); SBAR();
    pv_d0(o, vb0 + SHM_V, pa0, pa1, pa2, pa3); if (!PVA(13)) partialSM(pA0, pA1, m_reg, mnA, alA);
    if (!PVA(14)) __syncthreads(); if (!PVA(12)) { SWAIT(); SWRITE(1); }
    RESC(alA); if (!PVA(14)) __syncthreads();
  }
  SBAR(); qkt(pB0, pB1, KN_lds + SHM_KN, KR_lds + SHM_KR, qr, qrl, r32, hi);
  finishSM(pA0, pA1, alA, l_reg, pa0, pa1, pa2, pa3); SBAR();
  pv_d0(o, vb0, pa0, pa1, pa2, pa3); partialSM(pB0, pB1, m_reg, mnB, alB);
  __syncthreads(); RESC(alB);
  finishSM(pB0, pB1, alB, l_reg, pa0, pa1, pa2, pa3); SBAR();
  pv_d0(o, vb0 + SHM_V, pa0, pa1, pa2, pa3);
  if (hi == 0) li_l[r32] = l_reg; asm volatile("s_waitcnt lgkmcnt(0)" ::: "memory");
  float rli[16];
#pragma unroll
  for (int r = 0; r < 16; ++r) rli[r] = __builtin_amdgcn_rcpf(li_l[crow(r, hi)]);
  __syncthreads();
  { char* ost = lds + OFF_V + wid * 8192;
    unsigned obase = (unsigned)(uintptr_t)ost + hi * 1024 + r32 * 2; asm volatile("" : "+v"(obase));
#pragma unroll
    for (int r = 0; r < 16; ++r) {
#pragma unroll
      for (int d0 = 0; d0 < 4; ++d0) *(__attribute__((address_space(3))) unsigned short*)(uintptr_t)(obase + crow(r, 0) * 256 + d0 * 64) = (unsigned short)f2bf(o[d0][r] * rli[r]); }
    asm volatile("s_waitcnt lgkmcnt(0)" ::: "memory");
    unsigned short* Ow = Ob + (long)(wid * 32) * 1024;
    if (!dry) {
      const unsigned gvo = (unsigned)(lane >> 4) * 2048u + (unsigned)(lane & 15) * 16u;
#pragma unroll
      for (int q = 0; q < 8; ++q) *(u32x4*)((char*)Ow + (size_t)q * 8192 + gvo) = *(const u32x4*)(ost + (q * 64 + lane) * 16); } }
  __syncthreads();
#undef SLOAD
#undef SWRITE
#undef SWAIT
#undef RESC
}
#undef KSWZ
#undef KRSWZ
#undef SBAR
}

struct Ctx {
    LAS unsigned char* lds; unsigned char* ws; float* out;
    int tid, lane, wave, G, bid, gw, NGW;
    const float *x, *c, *w_mod, *b_mod, *g_mix, *w_in, *conv_w, *a_log, *dt_bias, *dn_o_gain, *q_gain, *w_uq, *kv_gain, *w_ukv, *w_o_dn, *w_o_mla, *w_out, *g_ffn, *w_router, *w_gate, *w_up, *w_down, *g_final;
    const int* positions;
};

template <class RowMap>
__device__ __forceinline__ void transpose_item(const float* W, int K, int N, bf16* WT, const float* kscale, LAS float* scr, int item, int lane, RowMap rm) {
    const int nblk = N / 32, kb = item / nblk, nb = item % nblk, k0 = 64 * kb, n0 = 32 * nb;
    { float tv[32];
#pragma unroll
      for (int i = 0; i < 32; ++i) { const int kk = 2 * i + (lane >> 5); tv[i] = W[(size_t)(k0 + kk) * N + n0 + (lane & 31)]; }
#pragma unroll
      for (int i = 0; i < 32; ++i) { const int kk = 2 * i + (lane >> 5); float v = tv[i]; if (kscale) v *= kscale[k0 + kk]; scr[kk * 33 + (lane & 31)] = v; } }
    LDS_WAIT(); asm volatile("" ::: "memory");
    const int c = lane & 7;
#pragma unroll
    for (int j = 0; j < 4; ++j) { const int n = (lane >> 3) + 8 * j; const LAS float* s = scr + (8 * c) * 33 + n;
        v4u o; o.x = pk2(s[0 * 33], s[1 * 33]); o.y = pk2(s[2 * 33], s[3 * 33]); o.z = pk2(s[4 * 33], s[5 * 33]); o.w = pk2(s[6 * 33], s[7 * 33]);
        *(GAS v4u*)(WT + (size_t)rm(n0 + n) * K + k0 + 8 * c) = o; }
    LDS_WAIT(); asm volatile("" ::: "memory");
}
__device__ __forceinline__ int win_dest_row(int s) {
    if (s < 4096) return s;
    if (s < 4112) return 6912 + 64 + (s - 4096);
    if (s < 4128) return 6912 + 80 + (s - 4112);
    if (s < 4640) return 6144 + (s - 4128);
    if (s < 4896) return 6656 + (s - 4640);
    if (s < 4960) { const int i = s - 4896; return 6912 + (i < 32 ? 2 * i : 2 * (i - 32) + 1); }
    return 4096 + (s - 4960);
}
__device__ __forceinline__ int wuq_dest_row(int s) { const int h = s / QKD, o = s % QKD; if (o < NOPE) return s; const int i = o - NOPE; return h * QKD + NOPE + (i < 32 ? 2 * i : 2 * (i - 32) + 1); }

__device__ __forceinline__ void p0_prologue(const Ctx& C0) {
    Ctx C = C0; asm volatile("" : "+v"(C.tid)); C.lane = C.tid & 63;
    float* mod = (float*)(C.ws + WS_MOD);
    if (C.bid < 96) {
        LAS float* sc = (LAS float*)C.lds;
        LAS float* red = (LAS float*)(C.lds + 16384);
        for (int i = C.tid; i < 4096; i += 512) sc[i] = siluf_(C.c[i]);
        __syncthreads();
        const int col = C.bid * 64 + C.lane; float a0 = 0.f, a1 = 0.f, a2 = 0.f, a3 = 0.f;
        for (int k0 = C.wave * 128; k0 < C.wave * 128 + 128; k0 += 16) { float wv[16];
#pragma unroll
            for (int i = 0; i < 16; ++i) wv[i] = C.w_mod[(size_t)(k0 + i) * 6144 + col];
#pragma unroll
            for (int i = 0; i < 16; ++i) { const int k = k0 + i; a0 += sc[k] * wv[i]; a1 += sc[1024 + k] * wv[i]; a2 += sc[2048 + k] * wv[i]; a3 += sc[3072 + k] * wv[i]; } }
        red[(C.wave * 4 + 0) * 64 + C.lane] = a0; red[(C.wave * 4 + 1) * 64 + C.lane] = a1; red[(C.wave * 4 + 2) * 64 + C.lane] = a2; red[(C.wave * 4 + 3) * 64 + C.lane] = a3;
        __syncthreads();
        if (C.wave < 4) { float s = C.b_mod[col];
#pragma unroll
            for (int w = 0; w < 8; ++w) s += red[(w * 4 + C.wave) * 64 + C.lane];
            mod[C.wave * 6144 + col] = s; }
        __syncthreads();
    }
    LAS float* scr = (LAS float*)(C.lds + C.wave * 16384);
    constexpr int I_IN = 16 * 219, I_UQ = 8 * 48, I_UKV = 4 * 64, I_SQ = 16 * 32;
    constexpr int NITEMS = I_IN + I_UQ + I_UKV + 3 * I_SQ;
    bf16* win_t = (bf16*)(C.ws + WS_WIN);
    for (int it = C.gw; it < NITEMS; it += C.NGW) {
        int r = it;
        if (r < I_IN) { transpose_item(C.w_in, 1024, 7008, win_t, nullptr, scr, r, C.lane, [](int s) { return win_dest_row(s); }); continue; } r -= I_IN;
        if (r < I_UQ) { transpose_item(C.w_uq, 512, 1536, (bf16*)(C.ws + WS_WUQ), C.q_gain, scr, r, C.lane, [](int s) { return wuq_dest_row(s); }); continue; } r -= I_UQ;
        if (r < I_UKV) { transpose_item(C.w_ukv, 256, 2048, (bf16*)(C.ws + WS_WUKV), C.kv_gain, scr, r, C.lane, [](int s) { return s; }); continue; } r -= I_UKV;
        if (r < I_SQ) { transpose_item(C.w_o_dn, 1024, 1024, (bf16*)(C.ws + WS_WODN), nullptr, scr, r, C.lane, [](int s) { return s; }); continue; } r -= I_SQ;
        if (r < I_SQ) { transpose_item(C.w_o_mla, 1024, 1024, (bf16*)(C.ws + WS_WOMLA), nullptr, scr, r, C.lane, [](int s) { return s; }); continue; } r -= I_SQ;
        transpose_item(C.w_out, 1024, 1024, (bf16*)(C.ws + WS_WOUT), nullptr, scr, r, C.lane, [](int s) { return s; });
    }
    { v4u zz = {0u, 0u, 0u, 0u}; GAS v4u* p = (GAS v4u*)(win_t + (size_t)7008 * 1024);
      for (int i = C.bid * 512 + C.tid; i < 160 * 1024 / 8; i += C.G * 512) p[i] = zz; }
    if (C.bid == 0) for (int i = C.tid; i < 3072 * 2 / 16; i += 512) *(GAS v4u*)(C.ws + WS_ZROW + (size_t)i * 16) = (v4u){0u, 0u, 0u, 0u};
    { float* cs = (float*)(C.ws + WS_CS);
      for (int i = C.bid * 512 + C.tid; i < NTOK * 32; i += C.G * 512) { const int tok = i >> 5, k = i & 31;
          const float inv_freq = powf(10000.0f, -(float)k / 32.0f); const float ang = (float)C.positions[tok] * inv_freq;
          float s, c; sincosf(ang, &s, &c); cs[2 * i] = c; cs[2 * i + 1] = s; } }
}

__device__ __forceinline__ void p1_h(const Ctx& C0) {
    Ctx C = C0; asm volatile("" : "+v"(C.tid)); C.lane = C.tid & 63;
    const float* mod = (const float*)(C.ws + WS_MOD); bf16* h = (bf16*)(C.ws + WS_A);
    for (int m = C.gw; m < NTOK; m += C.NGW) { const int b = m / SEQ;
        const GAS f32x4* xr = (const GAS f32x4*)(C.x + (size_t)m * DM) + C.lane; f32x4 v[4]; float s = 0.f;
#pragma unroll
        for (int j = 0; j < 4; ++j) { v[j] = xr[64 * j]; s += (v[j].x * v[j].x + v[j].y * v[j].y) + (v[j].z * v[j].z + v[j].w * v[j].w); }
        const float rstd = rsqrtf(wave_sum(s) * (1.f / DM) + EPS);
        GAS v2u* o8 = (GAS v2u*)(h + (size_t)m * DM) + C.lane;
#pragma unroll
        for (int j = 0; j < 4; ++j) { const int col = 4 * C.lane + 256 * j;
            const f32x4 gm = *(const f32x4*)(C.g_mix + col), sh = *(const f32x4*)(mod + b * 6144 + col), sc = *(const f32x4*)(mod + b * 6144 + 1024 + col);
            const f32x4 y = v[j] * rstd * gm * (sc + 1.f) + sh; v2u w; w.x = pk2(y.x, y.y); w.y = pk2(y.z, y.w); o8[64 * j] = w; } }
}

__device__ __forceinline__ void p7_dnout(const Ctx& C0) {
    Ctx C = C0; asm volatile("" : "+v"(C.tid)); C.lane = C.tid & 63;
    const bf16* odir = (const bf16*)(C.ws + WS_ODIR); const bf16* z = (const bf16*)(C.ws + WS_Z); bf16* dno = (bf16*)C.out;
    for (int m = C.gw; m < NTOK; m += C.NGW) { const int c0 = C.lane * 16;
        f32x4 f[4], r[4], zz[4];
        { const GAS v4u* p = (const GAS v4u*)(odir + (size_t)m * 1024 + c0); unpack8(p[0], f[0], f[1]); unpack8(p[1], f[2], f[3]); }
        { const GAS v4u* p = (const GAS v4u*)(odir + ((size_t)NTOK + m) * 1024 + c0); unpack8(p[0], r[0], r[1]); unpack8(p[1], r[2], r[3]); }
        { const GAS v4u* p = (const GAS v4u*)(z + (size_t)m * 1024 + c0); unpack8(p[0], zz[0], zz[1]); unpack8(p[1], zz[2], zz[3]); }
        float s = 0.f;
#pragma unroll
        for (int j = 0; j < 4; ++j) { f[j] = f[j] + r[j]; s += (f[j].x * f[j].x + f[j].y * f[j].y) + (f[j].z * f[j].z + f[j].w * f[j].w); }
        s += __shfl_xor(s, 1); s += __shfl_xor(s, 2); s += __shfl_xor(s, 4);
        const float rstd = rsqrtf(s * (1.f / DHD) + EPS);
#pragma unroll
        for (int j = 0; j < 4; ++j) { const f32x4 og = *(const f32x4*)(C.dn_o_gain + (c0 & 127) + 4 * j);
#pragma unroll
            for (int e = 0; e < 4; ++e) f[j][e] = f[j][e] * rstd * og[e] * siluf_(zz[j][e]); }
        GAS v4u* o = (GAS v4u*)(dno + (size_t)m * 1024 + c0); o[0] = pack8(f[0], f[1]); o[1] = pack8(f[2], f[3]); }
}

__device__ __forceinline__ const bf16* x1_row(const unsigned char* ws, int m) { return (m < 8192) ? (const bf16*)(ws + WS_X1A) + (size_t)m * DM : (const bf16*)(ws + WS_X1B) + (size_t)(m - 8192) * DM; }
__device__ __forceinline__ f32x4 unpack4(const v2u w) { f32x4 r; r.x = bflo(w.x); r.y = bfhi(w.x); r.z = bflo(w.y); r.w = bfhi(w.y); return r; }
constexpr int RT_PITCH = 2064, RT_PART = 16 * RT_PITCH, RT_GA = 3 * RT_PART, RT_GB = RT_GA + 4096, RT_HS = RT_GB + 4096, RT_H = RT_HS + 512;
__device__ __forceinline__ void p11_h2(const Ctx& C0, int var = 0) {
    Ctx C = C0; asm volatile("" : "+v"(C.tid)); C.lane = C.tid & 63;
    const float* mod = (const float*)(C.ws + WS_MOD); bf16* h2 = (bf16*)(C.ws + WS_A); float* aff = (float*)(C.ws + WS_AFF);
    LAS unsigned char* L = C.lds; LAS float* GAl = (LAS float*)(L + RT_GA); LAS float* GBl = (LAS float*)(L + RT_GB); LAS float* HS = (LAS float*)(L + RT_HS); LAS float* Hl = (LAS float*)(L + RT_H);
    for (int blk = C.bid; blk < NTOK / 64; blk += C.G) { const int T0 = blk * 64, b = T0 / SEQ;
        for (int i = C.tid; i < DM; i += NWAVES * 64) { GAl[i] = C.g_ffn[i] * (mod[b * 6144 + 4096 + i] + 1.f); GBl[i] = mod[b * 6144 + 3072 + i]; }
        __syncthreads();
        { float hp = 0.f; const int e = C.tid & 15;
#pragma unroll 4
          for (int k = 0; k < 16; ++k) { const int cp = (C.tid + 512 * k) >> 4, c0 = 2 * cp; const float w0 = C.w_router[c0 * 16 + e], w1 = C.w_router[c0 * 16 + 16 + e];
              float g0 = GAl[c0] * w0, g1 = GAl[c0 + 1] * w1; hp += GBl[c0] * w0 + GBl[c0 + 1] * w1;
#pragma unroll
              for (int p = 0; p < 3; ++p) { const unsigned pk = pk2(g0, g1); *(LAS unsigned*)(L + p * RT_PART + e * RT_PITCH + c0 * 2) = pk; g0 -= bflo(pk); g1 -= bfhi(pk); } }
          hp += __shfl_xor(hp, 16); hp += __shfl_xor(hp, 32); if (C.lane < 16) HS[C.wave * 16 + C.lane] = hp; }
        __syncthreads();
        if (C.tid < 16) { float h = 0.f;
#pragma unroll
            for (int w = 0; w < NWAVES; ++w) h += HS[w * 16 + C.tid]; Hl[C.tid] = h; }
        __syncthreads();
        if (C.wave < 4) { int ln_ = C.lane; asm volatile("" : "+v"(ln_));
            const int tl = ln_ & 15, kg = ln_ >> 4, tok = T0 + 16 * C.wave + tl;
            const GAS v4u* xr = (const GAS v4u*)(x1_row(C.ws, tok) + 8 * kg);
            v4u xv[32];
#pragma unroll
            for (int s_ = 0; s_ < 32; ++s_) xv[s_] = xr[4 * s_];
            f32x4 acc = {0.f, 0.f, 0.f, 0.f}; float ssq = 0.f;
            const LAS unsigned char* gb_ = L + tl * RT_PITCH + 16 * kg;
#pragma unroll
            for (int s_ = 0; s_ < 32; ++s_) { const bf16x8 a = __builtin_bit_cast(bf16x8, xv[s_]);
#pragma unroll
                for (int p = 0; p < 3; ++p) acc = __builtin_amdgcn_mfma_f32_16x16x32_bf16(a, *(const LAS bf16x8*)(gb_ + p * RT_PART + 64 * s_), acc, 0, 0, 0);
                const v4u w = xv[s_]; const float x0 = bflo(w.x), x1_ = bfhi(w.x), x2 = bflo(w.y), x3 = bfhi(w.y), x4 = bflo(w.z), x5 = bfhi(w.z), x6 = bflo(w.w), x7 = bfhi(w.w);
                ssq += ((x0 * x0 + x1_ * x1_) + (x2 * x2 + x3 * x3)) + ((x4 * x4 + x5 * x5) + (x6 * x6 + x7 * x7));
                if (s_ & 1) asm volatile("" : "+v"(acc) :: "memory"); }
            ssq += __shfl_xor(ssq, 16); ssq += __shfl_xor(ssq, 32);
            const float rstd = rsqrtf(ssq * (1.f / DM) + EPS);
            GAS v4u* ho = (GAS v4u*)(h2 + (size_t)tok * DM + 8 * kg); const LAS unsigned char* gab_ = L + RT_GA + 32 * kg;
#pragma unroll
            for (int s_ = 0; s_ < 32; ++s_) { const f32x4 ga0 = *(const LAS f32x4*)(gab_ + 128 * s_), ga1 = *(const LAS f32x4*)(gab_ + 128 * s_ + 16), gb0 = *(const LAS f32x4*)(gab_ + 4096 + 128 * s_), gb1 = *(const LAS f32x4*)(gab_ + 4096 + 128 * s_ + 16);
                v4u w = xv[s_]; asm volatile("" : "+v"(w)); v4u o;
                o.x = pk2(bflo(w.x) * rstd * ga0[0] + gb0[0], bfhi(w.x) * rstd * ga0[1] + gb0[1]); o.y = pk2(bflo(w.y) * rstd * ga0[2] + gb0[2], bfhi(w.y) * rstd * ga0[3] + gb0[3]);
                o.z = pk2(bflo(w.z) * rstd * ga1[0] + gb1[0], bfhi(w.z) * rstd * ga1[1] + gb1[1]); o.w = pk2(bflo(w.w) * rstd * ga1[2] + gb1[2], bfhi(w.w) * rstd * ga1[3] + gb1[3]);
                if (!((var >> 18) & 1)) ho[4 * s_] = o;
                if (s_ & 1) asm volatile("" ::: "memory"); }
            const float he = Hl[tl];
#pragma unroll
            for (int r = 0; r < 4; ++r) { const float lgt = acc[r] * __shfl(rstd, 4 * kg + r) + he; float mx = lgt;
#pragma unroll
                for (int o = 1; o < 16; o <<= 1) mx = fmaxf(mx, __shfl_xor(mx, o));
                const float ex = __expf(lgt - mx); float den = ex;
#pragma unroll
                for (int o = 1; o < 16; o <<= 1) den += __shfl_xor(den, o);
                if (!((var >> 17) & 1)) aff[(size_t)(T0 + 16 * C.wave + 4 * kg + r) * NE + tl] = ex / den; } }
        __syncthreads(); }
}

__device__ __forceinline__ void p12_topk(const Ctx& C0) {
    Ctx C = C0; asm volatile("" : "+v"(C.tid)); C.lane = C.tid & 63;
    if (C.bid < NB * NE) {
        const float* aff = (const float*)(C.ws + WS_AFF); int* idx = (int*)(C.ws + WS_IDX) + C.bid * CAP; float* gatew = (float*)(C.ws + WS_GATEW) + C.bid * CAP;
        int* slot = (int*)(C.ws + WS_SLOT) + (size_t)C.bid * SEQ;
        LAS unsigned* hist = (LAS unsigned*)C.lds;
        LAS unsigned* sel = hist + 256;
        LAS unsigned* wsum = hist + 264;
        LAS int* lidx = (LAS int*)(hist + 512);
        unsigned key[8];
        { const GAS unsigned* p = (const GAS unsigned*)aff + ((size_t)(C.bid >> 4) * SEQ + C.tid * 8) * NE + (C.bid & 15);
#pragma unroll
          for (int j = 0; j < 8; ++j) key[j] = p[j * NE]; }
        unsigned prefix = 0u, krem = CAP;
        for (int pass = 0; pass < 4; ++pass) { const int shift = 24 - 8 * pass;
            if (C.tid < 256) hist[C.tid] = 0u;
            __syncthreads();
#pragma unroll
            for (int j = 0; j < 8; ++j) { const bool match = (pass == 0) || ((key[j] >> (shift + 8)) == prefix); if (match) __hip_atomic_fetch_add(&hist[(key[j] >> shift) & 255u], 1u, __ATOMIC_RELAXED, __HIP_MEMORY_SCOPE_WORKGROUP); }
            __syncthreads();
            if (C.wave == 0) { const unsigned c0 = hist[4 * C.lane], c1 = hist[4 * C.lane + 1], c2 = hist[4 * C.lane + 2], c3 = hist[4 * C.lane + 3]; const unsigned s = c0 + c1 + c2 + c3;
                unsigned suf = s;
#pragma unroll
                for (int o = 1; o < 64; o <<= 1) { const unsigned t2 = __shfl_down(suf, o); if (C.lane + o < 64) suf += t2; }
                const unsigned above = suf - s;
                if (above < krem && krem <= suf) { unsigned run = above; int bin;
                    if (run + c3 >= krem) bin = 3; else { run += c3; if (run + c2 >= krem) bin = 2; else { run += c2; if (run + c1 >= krem) bin = 1; else { run += c1; bin = 0; } } }
                    sel[0] = 4 * C.lane + bin; sel[1] = krem - run; } }
            __syncthreads();
            prefix = (prefix << 8) | sel[0]; krem = sel[1];
            __syncthreads();
        }
        unsigned ngt = 0u, neq = 0u;
#pragma unroll
        for (int j = 0; j < 8; ++j) { ngt += key[j] > prefix; neq += key[j] == prefix; }
        unsigned igt = ngt, ieq = neq;
#pragma unroll
        for (int o = 1; o < 64; o <<= 1) { const unsigned a = __shfl_up(igt, o), b2 = __shfl_up(ieq, o); if (C.lane >= o) { igt += a; ieq += b2; } }
        if (C.lane == 63) { wsum[C.wave * 2] = igt; wsum[C.wave * 2 + 1] = ieq; }
        __syncthreads();
        unsigned bgt = igt - ngt, beq = ieq - neq;
        for (int w = 0; w < C.wave; ++w) { bgt += wsum[w * 2]; beq += wsum[w * 2 + 1]; }
#pragma unroll
        for (int j = 0; j < 8; ++j) { const int t = C.tid * 8 + j; int sl = -1;
            if (key[j] > prefix) { sl = (int)(bgt + (beq < krem ? beq : krem)); ++bgt; }
            else if (key[j] == prefix) { if (beq < krem) sl = (int)(bgt + beq); ++beq; }
            slot[t] = sl; if (sl >= 0) { idx[sl] = (C.bid >> 4) * SEQ + t; gatew[sl] = __builtin_bit_cast(float, key[j]); } }
        __syncthreads();
    }
    LAS float* scr = (LAS float*)(C.lds + C.wave * 16384);
    bf16* wgu = (bf16*)(C.ws + WS_WGU); bf16* wd = (bf16*)(C.ws + WS_WD);
    const int nA = (16 * 3 * 512 * 8) / 10  , nB = 16 * 3 * 512 - nA, gwB = (C.bid - NB * NE) * NWAVES + C.wave, ngwB = (C.G - NB * NE) * NWAVES;
    const int cntA = (nA - C.gw + C.NGW - 1) / C.NGW, cntB = (C.bid >= NB * NE && ngwB > 0) ? (nB - gwB + ngwB - 1) / ngwB : 0;
    for (int q = 0; q < cntA + cntB; ++q) { const int it = (q < cntA) ? C.gw + q * C.NGW : nA + gwB + (q - cntA) * ngwB;
        const int e = it / 1536, r = it % 1536, which = r / 512, item = r % 512;
        if (which == 0) transpose_item(C.w_gate + (size_t)e * 1048576, 1024, 1024, wgu + (size_t)e * 2048 * 1024, nullptr, scr, item, C.lane, [](int s) { return 8 * (s >> 2) + (s & 3); });
        else if (which == 1) transpose_item(C.w_up + (size_t)e * 1048576, 1024, 1024, wgu + (size_t)e * 2048 * 1024, nullptr, scr, item, C.lane, [](int s) { return 8 * (s >> 2) + 4 + (s & 3); });
        else transpose_item(C.w_down + (size_t)e * 1048576, 1024, 1024, wd + (size_t)e * 1024 * 1024, nullptr, scr, item, C.lane, [](int s) { return s; }); }
}

__device__ __forceinline__ void p16_final(const Ctx& C0) {
    Ctx C = C0; asm volatile("" : "+v"(C.tid)); C.lane = C.tid & 63;
    const float* mod = (const float*)(C.ws + WS_MOD); const bf16* ye = (const bf16*)(C.ws + WS_YE); const int* slot = (const int*)(C.ws + WS_SLOT);
    typedef int i32x4 __attribute__((ext_vector_type(4)));
    for (int q = C.gw; q < NTOK / 4; q += C.NGW) { const int m0 = 4 * q, b = m0 / SEQ, t0 = m0 % SEQ;
        i32x4 s4 = {-1, -1, -1, -1};
        if (C.lane < NE) s4 = *(const GAS i32x4*)(slot + ((size_t)b * NE + C.lane) * SEQ + t0);
        f32x4 g2[4];
#pragma unroll
        for (int j = 0; j < 4; ++j) g2[j] = *(const f32x4*)(mod + b * 6144 + 5120 + 4 * C.lane + 256 * j);
        v2u xn[4];
        { const GAS v2u* xr0 = (const GAS v2u*)x1_row(C.ws, m0) + C.lane;
#pragma unroll
          for (int j = 0; j < 4; ++j) xn[j] = xr0[64 * j]; }
#pragma unroll
        for (int k = 0; k < 4; ++k) { const int m = m0 + k; const int myslot = s4[k];
            f32x4 v[4];
#pragma unroll
            for (int j = 0; j < 4; ++j) v[j] = unpack4(xn[j]);
            if (k < 3) { const GAS v2u* xr1 = (const GAS v2u*)x1_row(C.ws, m + 1) + C.lane;
#pragma unroll
                for (int j = 0; j < 4; ++j) xn[j] = xr1[64 * j]; }
            f32x4 acc[4];
#pragma unroll
            for (int j = 0; j < 4; ++j) acc[j] = (f32x4){0.f, 0.f, 0.f, 0.f};
            unsigned mask = (unsigned)__ballot(myslot >= 0) & 0xffffu;
            while (mask) { v2u w[4][4];
#pragma unroll
                for (int u = 0; u < 4; ++u) {
                    if (mask) { const int e = __ffs(mask) - 1; mask &= mask - 1u; const int sl = __shfl(myslot, e);
                        const GAS v2u* pp = (const GAS v2u*)(ye + ((size_t)(b * NE + e) * CAP + sl) * DM) + C.lane;
#pragma unroll
                        for (int j = 0; j < 4; ++j) w[u][j] = pp[64 * j]; }
                    else {
#pragma unroll
                        for (int j = 0; j < 4; ++j) w[u][j] = (v2u){0u, 0u}; } }
#pragma unroll
                for (int u = 0; u < 4; ++u)
#pragma unroll
                    for (int j = 0; j < 4; ++j) { acc[j].x += bflo(w[u][j].x); acc[j].y += bfhi(w[u][j].x); acc[j].z += bflo(w[u][j].y); acc[j].w += bfhi(w[u][j].y); } }
            float s = 0.f;
#pragma unroll
            for (int j = 0; j < 4; ++j) { v[j] = v[j] + g2[j] * acc[j]; s += (v[j].x * v[j].x + v[j].y * v[j].y) + (v[j].z * v[j].z + v[j].w * v[j].w); }
            const float rstd = rsqrtf(wave_sum(s) * (1.f / DM) + EPS);
            GAS f32x4* xr = (GAS f32x4*)(C.out + (size_t)m * DM) + C.lane;
#pragma unroll
            for (int j = 0; j < 4; ++j) { const f32x4 gf = *(const f32x4*)(C.g_final + 4 * C.lane + 256 * j); xr[64 * j] = v[j] * rstd * gf; } } }
}

#define SW128(row, boff) ((row) * 128 + ((boff) ^ ((((row) >> 1) & 7) << 4)))
#define SW256(row, boff) ((row) * 256 + ((boff) ^ (((row) & 15) << 4)))
typedef float f32x16 __attribute__((ext_vector_type(16)));
__device__ __forceinline__ int crow32(int r, int hi) { return (r & 3) + 8 * (r >> 2) + 4 * hi; }

template <int REV>
__device__ __forceinline__ void tri_solve_ip(LAS float* Lm, LAS bf16* Tl, int lane) {
    LAS float* colp = Lm + (REV ? 63 - lane : lane); asm volatile("" : "+v"(colp));
    LAS float* dummy = (LAS float*)Tl + lane;
#pragma unroll
    for (int R = 0; R < 4; ++R) {
        float a[16];
#pragma unroll
        for (int ii = 0; ii < 16; ++ii) a[ii] = 0.f;
        f32x4 lq_[2][16]; float xr_[2][4];
#define TS_LOAD(jg_, b_) do { _Pragma("unroll") for (int e = 0; e < 4; ++e) { const int jl = 4 * (jg_) + e; xr_[b_][e] = colp[(REV ? 63 - jl : jl) * 64]; } \
            _Pragma("unroll") for (int ii = 0; ii < 16; ++ii) { const int il = 16 * R + ii; lq_[b_][ii] = REV ? *(const LAS f32x4*)(Lm + (63 - il) * 64 + 60 - 4 * (jg_)) : *(const LAS f32x4*)(Lm + il * 64 + 4 * (jg_)); } } while (0)
        if (R > 0) TS_LOAD(0, 0);
#pragma unroll
        for (int jg = 0; jg < 4 * R; ++jg) { const int cb = jg & 1;
            if (jg + 1 < 4 * R) TS_LOAD(jg + 1, cb ^ 1);
            float xv[4];
#pragma unroll
            for (int e = 0; e < 4; ++e) { const int jl = 4 * jg + e; xv[e] = (lane < jl) ? xr_[cb][e] : ((lane == jl) ? 1.f : 0.f); }
#pragma unroll
            for (int ii = 0; ii < 16; ++ii) { const f32x4 l4 = lq_[cb][ii];
                a[ii] = fmaf(-(REV ? l4[3] : l4[0]), xv[0], a[ii]); a[ii] = fmaf(-(REV ? l4[2] : l4[1]), xv[1], a[ii]); a[ii] = fmaf(-(REV ? l4[1] : l4[2]), xv[2], a[ii]); a[ii] = fmaf(-(REV ? l4[0] : l4[3]), xv[3], a[ii]); }
            asm volatile("" : "+v"(a[0]), "+v"(a[1]), "+v"(a[2]), "+v"(a[3]), "+v"(a[4]), "+v"(a[5]), "+v"(a[6]), "+v"(a[7]), "+v"(a[8]), "+v"(a[9]), "+v"(a[10]), "+v"(a[11]), "+v"(a[12]), "+v"(a[13]), "+v"(a[14]), "+v"(a[15]) :: "memory");
        }
#undef TS_LOAD
        f32x4 p2[16][4];
#pragma unroll
        for (int ii = 1; ii < 16; ++ii) { const int il = 16 * R + ii;
#pragma unroll
            for (int q = 0; q < (ii + 3) / 4; ++q) { const int j0 = 16 * R + 4 * q; p2[ii][q] = REV ? *(const LAS f32x4*)(Lm + (63 - il) * 64 + 60 - j0) : *(const LAS f32x4*)(Lm + il * 64 + j0); } }
        float xb[16];
#pragma unroll
        for (int ii = 0; ii < 16; ++ii) { const int il = 16 * R + ii; float acc = a[ii] + ((lane == il) ? 1.f : 0.f), acc2 = 0.f;
#pragma unroll
            for (int q = 0; q < (ii + 3) / 4; ++q) { const f32x4 l4 = p2[ii][q];
                if (4 * q + 0 < ii) acc -= (REV ? l4[3] : l4[0]) * xb[4 * q + 0];
                if (4 * q + 1 < ii) acc2 -= (REV ? l4[2] : l4[1]) * xb[4 * q + 1];
                if (4 * q + 2 < ii) acc -= (REV ? l4[1] : l4[2]) * xb[4 * q + 2];
                if (4 * q + 3 < ii) acc2 -= (REV ? l4[0] : l4[3]) * xb[4 * q + 3]; }
            xb[ii] = acc + acc2; }
        asm volatile("" : "+v"(xb[15]) :: "memory");
#pragma unroll
        for (int ii = 0; ii < 16; ++ii) { const int il = 16 * R + ii; LAS float* wp = (lane < il) ? colp + (REV ? 63 - il : il) * 64 : dummy; *wp = xb[ii]; }
        asm volatile("" : "+v"(lane), "+v"(colp), "+v"(dummy) :: "memory");
    }
    int pc = lane; asm volatile("" : "+v"(pc));
    const LAS float* src = Lm + pc; LAS bf16* dst = Tl + pc;
#pragma unroll
    for (int i = 0; i < 64; ++i) { const float v = src[i * 64]; const bool mine = REV ? (pc > i) : (pc < i); dst[i * 64] = (bf16)f2bf(mine ? v : ((pc == i) ? 1.f : 0.f)); }
}
typedef short s16x4_t __attribute__((ext_vector_type(4)));

constexpr size_t T2_OFF = (size_t)NB * DNH * 64 * 2 * 4096;
constexpr int DN_RAW = 0, DN_KBUF = 53248, DN_LMAT = 69632, DN_GCS = 135168, DN_RNL = 139264;
__device__ __forceinline__ void p5_chunk(const Ctx& C0, int reps) {
    Ctx C = C0; asm volatile("" : "+v"(C.tid)); C.lane = C.tid & 63;
    bf16* qkv = (bf16*)(C.ws + WS_QKV); const bf16* halo = (const bf16*)(C.ws + WS_HALO); const bf16* zrow = (const bf16*)(C.ws + WS_ZROW);
    const float* beta = (const float*)(C.ws + WS_BETA); const float* gg = (const float*)(C.ws + WS_G); float* gcg = (float*)(C.ws + WS_GC); float* cbg = (float*)(C.ws + WS_CB); float* btg = (float*)(C.ws + WS_BT); bf16* Tbuf = (bf16*)C.out;
    LAS unsigned char* raw = C.lds + DN_RAW; LAS unsigned char* kbuf = C.lds + DN_KBUF; LAS float* rnl = (LAS float*)(C.lds + DN_RNL) + C.wave * 32;
    const int nun = (512 * reps - C.bid + C.G - 1) / C.G, nch = nun * 4;
#ifndef PROBE_VARIANT
#define PROBE_VARIANT 0
#endif
#define PV5(bit) (!wr && ((PROBE_VARIANT >> (bit)) & 1))
    v4u pre[7];
#define PRE_LOAD(q_) do { const int u1_ = C.bid + ((q_) >> 2) * C.G, u_ = u1_ & 511, n_ = (u_ & 15) * 4 + ((q_) & 3), h_ = (u_ >> 4) & 7, b_ = u_ >> 7, gch_ = b_ * 64 + n_; const size_t gr0_ = (size_t)b_ * SEQ + n_ * 64; \
        _Pragma("unroll") for (int it = 0; it < 7; ++it) { int idx = C.tid + 512 * it; if (it == 6 && idx >= 68 * 48) idx = 0; const int r = idx / 48, ch = idx % 48, col = (ch >> 4) * 1024 + h_ * 128 + (ch & 15) * 8; \
            const bf16* top = (n_ > 0) ? halo + (size_t)((gch_ - 1) * 4 + 2 + r) * 3072 : zrow; const bf16* bot = (n_ < 63) ? halo + (size_t)((gch_ + 1) * 4 + (r - 66)) * 3072 : zrow; \
            const bf16* mid = qkv + (gr0_ + r - 2) * 3072; const bf16* rowp = (r < 2) ? top : ((r >= 66) ? bot : mid); pre[it] = *(const GAS v4u*)(rowp + col); } } while (0)
    if (nch > 0) PRE_LOAD(0);
    for (int q = 0; q < nch; ++q) {
        const int u1 = C.bid + (q >> 2) * C.G, u = u1 & 511, c = q & 3; const bool wr = u1 < 512;
        const int grp = u & 15, h = (u >> 4) & 7, b = u >> 7, n = grp * 4 + c; const size_t gr0 = (size_t)b * SEQ + n * 64;
        int tid = C.tid; asm volatile("" : "+v"(tid)); const int lane = tid & 63;
        LAS float* gcs = (LAS float*)(C.lds + DN_GCS + c * 1024); LAS float* Lm = (LAS float*)(C.lds + DN_LMAT + c * 16384);
#pragma unroll
        for (int it = 0; it < 7; ++it) { const int idx = tid + 512 * it; if (it < 6 || idx < 68 * 48) { const int r = idx / 48, ch = idx % 48; *(LAS v4u*)(raw + r * 768 + ch * 16) = pre[it]; } }
        if (C.wave == 6) { float s = gg[(gr0 + lane) * 16 + h];
#pragma unroll
            for (int o = 1; o < 64; o <<= 1) { const float t2 = __shfl_up(s, o); if (lane >= o) s += t2; }
            const float bt_ = beta[(gr0 + lane) * 16 + h]; const size_t so_ = ((size_t)(0 * NB + b) * DNH + h) * SEQ + n * 64 + lane; gcs[lane] = s; gcs[128 + lane] = bt_; gcg[so_] = s; cbg[so_] = bt_ * __expf(s); btg[so_] = bt_; }
        if (C.wave == 7) { float s = gg[(gr0 + lane) * 16 + 8 + h];
#pragma unroll
            for (int o = 1; o < 64; o <<= 1) { const float t2 = __shfl_down(s, o); if (lane + o < 64) s += t2; }
            const float bt_ = beta[(gr0 + lane) * 16 + 8 + h]; const size_t so_ = ((size_t)(1 * NB + b) * DNH + h) * SEQ + n * 64 + lane; gcs[64 + lane] = s; gcs[192 + lane] = bt_; gcg[so_] = s; cbg[so_] = bt_ * __expf(s); btg[so_] = bt_; }
        __syncthreads();
        if (q + 1 < nch && !PV5(11)) PRE_LOAD(q + 1);
        if (C.wave < 6 && !PV5(8)) { const int ten = C.wave >> 1, rh = C.wave & 1, gcol = ten * 1024 + h * 128 + 2 * lane;
            float w0[5], w1[5];
#pragma unroll
            for (int k = 0; k < 5; ++k) { w0[k] = C.conv_w[k * 3072 + gcol]; w1[k] = C.conv_w[k * 3072 + gcol + 1]; }
            const LAS unsigned char* rp = raw + ten * 256 + lane * 4 + rh * 32 * 768;
            float y0[32], y1[32];
            { float x0[36], x1[36];
#pragma unroll
              for (int r = 0; r < 36; ++r) { const unsigned w = *(const LAS unsigned*)(rp + r * 768); x0[r] = bflo(w); x1[r] = bfhi(w); }
#pragma unroll
              for (int r = 0; r < 32; ++r) { float a0 = 0.f, a1 = 0.f;
#pragma unroll
                  for (int k = 0; k < 5; ++k) { a0 += w0[k] * x0[r + k]; a1 += w1[k] * x1[r + k]; }
                  y0[r] = siluf_(a0); y1[r] = siluf_(a1); } }
            if (ten < 2) {
                float t[32];
#pragma unroll
                for (int r = 0; r < 32; ++r) t[r] = y0[r] * y0[r] + y1[r] * y1[r];
#pragma unroll
                for (int lv = 0; lv < 5; ++lv) { const int half = 16 >> lv, bit = 32 >> lv; const bool up = (lane & bit) != 0;
#pragma unroll
                    for (int r = 0; r < half; ++r) { float lo_ = t[r], hi_ = t[r + half]; asm volatile("" : "+v"(lo_), "+v"(hi_));
                        const float give = up ? lo_ : hi_, keep = up ? hi_ : lo_; t[r] = keep + __shfl_xor(give, bit); } }
                const float tot = t[0] + __shfl_xor(t[0], 1);
                rnl[(lane >> 1) & 31] = rsqrtf(tot + EPS) * (ten == 0 ? 0.08838834764831845f : 1.f);
                LDS_WAIT();
#pragma unroll
                for (int r4 = 0; r4 < 8; ++r4) { const f32x4 rn = *(const LAS f32x4*)(rnl + 4 * r4);
#pragma unroll
                    for (int e = 0; e < 4; ++e) { y0[4 * r4 + e] *= rn[e]; y1[4 * r4 + e] *= rn[e]; } } }
            unsigned pk[32];
#pragma unroll
            for (int r = 0; r < 32; ++r) pk[r] = cvtpk_c(y0[r], y1[r]);
            if (wr) { bf16* op = qkv + (gr0 + rh * 32) * 3072 + gcol;
#pragma unroll
                for (int r = 0; r < 32; ++r) *(GAS unsigned*)(op + (size_t)r * 3072) = pk[r]; }
            if (ten == 1) {
#pragma unroll
                for (int r = 0; r < 32; ++r) *(LAS unsigned*)(kbuf + SW256(rh * 32 + r, 4 * lane)) = pk[r]; } }
        __syncthreads();
        if (!PV5(9)) {
            const int ti = C.wave >> 1; int lr = lane & 15, lq = lane >> 4; asm volatile("" : "+v"(lr), "+v"(lq));
            bf16x8 ka[4];
#pragma unroll
            for (int ks = 0; ks < 4; ++ks) ka[ks] = *(const LAS bf16x8*)(kbuf + SW256(ti * 16 + lr, (ks * 32 + 8 * lq) * 2));
#pragma unroll
            for (int t2 = 0; t2 < 2; ++t2) { const int tj = 2 * (C.wave & 1) + t2; f32x4 acc = {0.f, 0.f, 0.f, 0.f};
#pragma unroll
                for (int ks = 0; ks < 4; ++ks) acc = __builtin_amdgcn_mfma_f32_16x16x32_bf16(ka[ks], *(const LAS bf16x8*)(kbuf + SW256(tj * 16 + lr, (ks * 32 + 8 * lq) * 2)), acc, 0, 0, 0);
                const int j = tj * 16 + lr; const float gfj = gcs[j], gbj = gcs[64 + j];
#pragma unroll
                for (int r = 0; r < 4; ++r) { const int i = ti * 16 + 4 * lq + r; float val = 0.f;
                    if (i > j) val = gcs[128 + i] * acc[r] * __expf(gcs[i] - gfj);
                    else if (i < j) val = gcs[192 + i] * acc[r] * __expf(gcs[64 + i] - gbj);
                    Lm[i * 64 + j] = val; } } }
        __syncthreads();
        if (c == 3 && !PV5(10)) {
            const int cs = C.wave >> 1, dir = C.wave & 1, ns = grp * 4 + cs; const LAS float* Ls = (const LAS float*)(C.lds + DN_LMAT + cs * 16384);
            bf16* Tg = Tbuf + ((size_t)(((b * DNH + h) * 64 + ns) * 2 + dir)) * 4096;
            LAS bf16* Tl = (LAS bf16*)(C.lds + C.wave * 8192);
            int ln = C.lane; asm volatile("" : "+v"(ln));
            if (dir == 0) tri_solve_ip<0>((LAS float*)Ls, Tl, ln); else tri_solve_ip<1>((LAS float*)Ls, Tl, ln);
            LDS_WAIT();
            const LAS unsigned char* tsrc = (const LAS unsigned char*)Tl + ln * 16; bf16* tdst = Tg + ln * 8;
            if (wr) { _Pragma("unroll") for (int q2 = 0; q2 < 8; ++q2) *(GAS v4u*)(tdst + q2 * 512) = *(const LAS v4u*)(tsrc + q2 * 1024); }
            __syncthreads();
        }
    }
#undef PRE_LOAD
}

constexpr int SC_K0 = 0, SC_Q0 = 32768, SC_T = 65536, SC_T2 = 73728, SC_V = 81920, SC_SC0 = 86016, SC_W = 88064, SC_IT = 104448, SC_UT = 112640, SC_ST = 120832, SC_VT = 129024, SC_VST = 133120, SC_OB = 137216;
typedef short s16x4_t __attribute__((ext_vector_type(4)));
__device__ __forceinline__ s16x4_t tr_rd(unsigned addr) { return __builtin_amdgcn_ds_read_tr16_b64_v4i16((LAS s16x4_t*)(uintptr_t)addr); }
__device__ __forceinline__ bf16x8 cat4(s16x4_t a, s16x4_t b) { return (bf16x8){a[0], a[1], a[2], a[3], b[0], b[1], b[2], b[3]}; }
#define SWU(row, chunk) ((row) * 256 + ((((chunk) ^ (row)) & 15) * 16))
__device__ __forceinline__ void p6_scan(const Ctx& C0, int reps) {
    Ctx C = C0; asm volatile("" : "+v"(C.tid)); C.lane = C.tid & 63;
    const bf16* qkv = (const bf16*)(C.ws + WS_QKV); const float* gcg = (const float*)(C.ws + WS_GC); const float* btg = (const float*)(C.ws + WS_BT); const float* cbg = (const float*)(C.ws + WS_CB);
    const bf16* Tbuf = (const bf16*)C.out; bf16* odir = (bf16*)(C.ws + WS_ODIR);
    LAS unsigned char* L = C.lds; const unsigned Lb = (unsigned)(uintptr_t)L;
    const int w = C.wave, lr = C.lane & 15, lq = C.lane >> 4, tq = lr >> 2, tp = lr & 3, rt = w >> 1, ct = w & 1;
    for (int u1 = C.bid; u1 < 256 * reps; u1 += C.G) { const int u0 = u1 & 255; const bool dry = u1 >= 256;
#define PVX(bit) (dry && ((PROBE_VARIANT >> (bit)) & 1))
        int dvs, seq; if (C.G == 256) { const int xcd = u0 & 7, j = u0 >> 3; dvs = j & 3; seq = (j >> 2) * 8 + xcd; } else { dvs = u0 & 3; seq = u0 >> 2; }
        const int dir = seq & 1, h = (seq >> 1) & 7, b = seq >> 4;
        f32x4 accS[2] = {{0.f, 0.f, 0.f, 0.f}, {0.f, 0.f, 0.f, 0.f}};
        v4u sk0, sk1, sq0, sq1, st0, sv0; f32x4 scb0, scb1; float sgc = 0.f, sbt = 0.f;
        const int ki = C.tid >> 4, kc8 = (C.tid & 15) * 8, ti_ = C.tid >> 3, tc8 = (C.tid & 7) * 8, vi = (C.tid & 255) >> 2, vc8 = (C.tid & 3) * 8;
        const size_t seqoff = ((size_t)(dir * NB + b) * DNH + h) * SEQ;
#define SC_LOAD(n_) do { const size_t gr0_ = (size_t)b * SEQ + (size_t)(n_) * 64; const bf16* kb_ = qkv + gr0_ * 3072 + 1024 + h * 128; const bf16* qb_ = qkv + gr0_ * 3072 + h * 128; \
        const bf16* tb_ = Tbuf + ((size_t)(((b * DNH + h) * 64 + (n_)) * 2 + dir)) * 4096 + ti_ * 64 + tc8; \
        sk0 = *(const GAS v4u*)(kb_ + (size_t)ki * 3072 + kc8); sk1 = *(const GAS v4u*)(kb_ + (size_t)(ki + 32) * 3072 + kc8); \
        sq0 = *(const GAS v4u*)(qb_ + (size_t)ki * 3072 + kc8); sq1 = *(const GAS v4u*)(qb_ + (size_t)(ki + 32) * 3072 + kc8); \
        st0 = *(const GAS v4u*)(tb_); scb0 = *(const GAS f32x4*)(cbg + seqoff + (n_) * 64 + tc8); scb1 = *(const GAS f32x4*)(cbg + seqoff + (n_) * 64 + tc8 + 4); \
        if (C.tid >= 256) { sv0 = *(const GAS v4u*)(qkv + (gr0_ + vi) * 3072 + 2048 + h * 128 + dvs * 32 + vc8); sbt = btg[seqoff + (n_) * 64 + vi]; } \
        if (C.tid < 64) sgc = gcg[seqoff + (n_) * 64 + C.tid]; } while (0)
#define SC_WRITE(buf_) do { LAS unsigned char* K_ = L + SC_K0 + (buf_) * 16384; LAS unsigned char* Q_ = L + SC_Q0 + (buf_) * 16384; \
        *(LAS v4u*)(K_ + SW256(ki, kc8 * 2)) = sk0; *(LAS v4u*)(K_ + SW256(ki + 32, kc8 * 2)) = sk1; \
        *(LAS v4u*)(Q_ + SW256(ki, kc8 * 2)) = sq0; *(LAS v4u*)(Q_ + SW256(ki + 32, kc8 * 2)) = sq1; \
        *(LAS v4u*)(L + SC_T + SW128(ti_, tc8 * 2)) = st0; { f32x4 ta_, tb2_; unpack8(st0, ta_, tb2_); *(LAS v4u*)(L + SC_T2 + SW128(ti_, tc8 * 2)) = pack8(ta_ * scb0, tb2_ * scb1); } \
        if (C.tid >= 256) { f32x4 va, vb; unpack8(sv0, va, vb); *(LAS v4u*)(L + SC_V + vi * 64 + vc8 * 2) = pack8(va * sbt, vb * sbt); } \
        if (C.tid < 64) { LAS float* sc_ = (LAS float*)(L + SC_SC0 + (buf_) * 1024); const float gl_ = __shfl(sgc, dir ? 0 : 63); sc_[C.tid] = sgc; sc_[64 + C.tid] = __expf(sgc); sc_[128 + C.tid] = __expf(gl_ - sgc); if (C.tid == 0) sc_[192] = __expf(gl_); } } while (0)
#define SC_PRODUCE_WU(kb_) do { const unsigned Kb_ = Lb + SC_K0 + (kb_) * 16384; \
        const s16x4_t k0 = tr_rd(Kb_ + SW256(8 * lq + tq, (w * 16 + 4 * tp) * 2)), k1 = tr_rd(Kb_ + SW256(8 * lq + 4 + tq, (w * 16 + 4 * tp) * 2)); \
        const s16x4_t k2 = tr_rd(Kb_ + SW256(32 + 8 * lq + tq, (w * 16 + 4 * tp) * 2)), k3 = tr_rd(Kb_ + SW256(32 + 8 * lq + 4 + tq, (w * 16 + 4 * tp) * 2)); \
        const bf16x8 ka_ = cat4(k0, k1), kb2_ = cat4(k2, k3); \
        _Pragma("unroll") for (int it = 0; it < 4; ++it) { \
            const bf16x8 bt0 = *(const LAS bf16x8*)(L + SC_T2 + SW128(it * 16 + lr, (8 * lq) * 2)), bt1 = *(const LAS bf16x8*)(L + SC_T2 + SW128(it * 16 + lr, (32 + 8 * lq) * 2)); \
            f32x4 a4 = __builtin_amdgcn_mfma_f32_16x16x32_bf16(ka_, bt0, (f32x4){0.f, 0.f, 0.f, 0.f}, 0, 0, 0); a4 = __builtin_amdgcn_mfma_f32_16x16x32_bf16(kb2_, bt1, a4, 0, 0, 0); \
            v2u pw_; pw_.x = cvtpk_c(a4[0], a4[1]); pw_.y = cvtpk_c(a4[2], a4[3]); *(LAS v2u*)(L + SC_W + SW256(it * 16 + lr, (w * 16 + 4 * lq) * 2)) = pw_; } \
        const bf16x8 at0 = *(const LAS bf16x8*)(L + SC_T + SW128(rt * 16 + lr, (8 * lq) * 2)), at1 = *(const LAS bf16x8*)(L + SC_T + SW128(rt * 16 + lr, (32 + 8 * lq) * 2)); \
        const s16x4_t v0 = tr_rd(Lb + SC_V + (8 * lq + tq) * 64 + (ct * 16 + 4 * tp) * 2), v1 = tr_rd(Lb + SC_V + (8 * lq + 4 + tq) * 64 + (ct * 16 + 4 * tp) * 2); \
        const s16x4_t v2 = tr_rd(Lb + SC_V + (32 + 8 * lq + tq) * 64 + (ct * 16 + 4 * tp) * 2), v3 = tr_rd(Lb + SC_V + (32 + 8 * lq + 4 + tq) * 64 + (ct * 16 + 4 * tp) * 2); \
        f32x4 u4 = __builtin_amdgcn_mfma_f32_16x16x32_bf16(at0, cat4(v0, v1), (f32x4){0.f, 0.f, 0.f, 0.f}, 0, 0, 0); u4 = __builtin_amdgcn_mfma_f32_16x16x32_bf16(at1, cat4(v2, v3), u4, 0, 0, 0); \
        *(LAS f32x4*)(L + SC_UT + SWU(ct * 16 + lr, rt * 4 + lq)) = u4; } while (0)
        __syncthreads();
        for (int i = C.tid; i < 8192 / 16; i += 512) *(LAS v4u*)(L + SC_ST + i * 16) = (v4u){0u, 0u, 0u, 0u};
        SC_LOAD(dir ? 63 : 0); SC_WRITE(0); SC_LOAD(dir ? 62 : 1);
        __syncthreads();
        SC_PRODUCE_WU(0);
        __syncthreads();
        for (int cc = 0; cc < 64; ++cc) {
            const int n = dir ? 63 - cc : cc, kb = cc & 1;
            LAS unsigned char* Kc = L + SC_K0 + kb * 16384; LAS unsigned char* Qc = L + SC_Q0 + kb * 16384; const LAS float* sc = (const LAS float*)(L + SC_SC0 + kb * 1024);
            const int i0 = rt * 16 + 4 * lq;
            if (!dry && cc > 0 && C.tid < 256) { const size_t grp_ = (size_t)b * SEQ + (size_t)(dir ? n + 1 : n - 1) * 64;
                *(GAS v4u*)(odir + ((size_t)dir * NTOK + grp_ + vi) * 1024 + h * 128 + dvs * 32 + vc8) = *(const LAS v4u*)(L + SC_OB + vi * 64 + vc8 * 2); }
            f32x4 accQ = {0.f, 0.f, 0.f, 0.f};
            if (!PVX(3)) {
                f32x4 accV = -*(const LAS f32x4*)(L + SC_UT + SWU(ct * 16 + lr, rt * 4 + lq));
                bf16x8 aq[4];
#pragma unroll
                for (int ks = 0; ks < 4; ++ks) { const int bo = (ks * 32 + 8 * lq) * 2; aq[ks] = *(const LAS bf16x8*)(Qc + SW256(rt * 16 + lr, bo));
                    const bf16x8 aw = *(const LAS bf16x8*)(L + SC_W + SW256(rt * 16 + lr, bo)), bs = *(const LAS bf16x8*)(L + SC_ST + SW256(ct * 16 + lr, bo));
                    accV = __builtin_amdgcn_mfma_f32_16x16x32_bf16(aw, bs, accV, 0, 0, 0); accQ = __builtin_amdgcn_mfma_f32_16x16x32_bf16(aq[ks], bs, accQ, 0, 0, 0); }
                const f32x4 di = *(const LAS f32x4*)(sc + 128 + i0); const f32x4 vn = -accV; v2u pw, qw; pw.x = cvtpk_c(vn[0], vn[1]); pw.y = cvtpk_c(vn[2], vn[3]);
                qw.x = cvtpk_c(vn[0] * di[0], vn[1] * di[1]); qw.y = cvtpk_c(vn[2] * di[2], vn[3] * di[3]);
                *(LAS v2u*)(L + SC_VT + SW128(ct * 16 + lr, i0 * 2)) = pw; *(LAS v2u*)(L + SC_VST + SW128(ct * 16 + lr, i0 * 2)) = qw;
                const float gci = sc[rt * 16 + lr]; const int ii = rt * 16 + lr;
#pragma unroll
                for (int t2 = 0; t2 < 2; ++t2) { const int jt = 2 * ct + t2; v2u iw; iw.x = 0u; iw.y = 0u;
                    if (!PVX(5) && (dir ? (jt >= rt) : (jt <= rt))) { f32x4 a4 = {0.f, 0.f, 0.f, 0.f};
#pragma unroll
                        for (int ks = 0; ks < 4; ++ks) a4 = __builtin_amdgcn_mfma_f32_16x16x32_bf16(*(const LAS bf16x8*)(Kc + SW256(jt * 16 + lr, (ks * 32 + 8 * lq) * 2)), aq[ks], a4, 0, 0, 0);
                        const f32x4 gj = *(const LAS f32x4*)(sc + jt * 16 + 4 * lq); float pv[4];
#pragma unroll
                        for (int r = 0; r < 4; ++r) { const int jj = jt * 16 + 4 * lq + r; const bool keep = (jt != rt) || (dir ? (ii <= jj) : (ii >= jj)); pv[r] = keep ? a4[r] * __expf(gci - gj[r]) : 0.f; }
                        iw.x = cvtpk_c(pv[0], pv[1]); iw.y = cvtpk_c(pv[2], pv[3]); }
                    *(LAS v2u*)(L + SC_IT + SW128(ii, (jt * 16 + 4 * lq) * 2)) = iw; } }
            if (cc + 1 < 64 && !PVX(4)) SC_WRITE(kb ^ 1);
            if (cc + 2 < 64 && !PVX(0)) SC_LOAD(dir ? 61 - cc : cc + 2);
            if (!PVX(1)) __syncthreads();
            if (!PVX(6)) {
                const bf16x8 ai0 = *(const LAS bf16x8*)(L + SC_IT + SW128(rt * 16 + lr, (8 * lq) * 2)), ai1 = *(const LAS bf16x8*)(L + SC_IT + SW128(rt * 16 + lr, (32 + 8 * lq) * 2));
                const f32x4 ei = *(const LAS f32x4*)(sc + 64 + i0);
                f32x4 accO = __builtin_amdgcn_mfma_f32_16x16x32_bf16(ai0, *(const LAS bf16x8*)(L + SC_VT + SW128(ct * 16 + lr, (8 * lq) * 2)), (f32x4){0.f, 0.f, 0.f, 0.f}, 0, 0, 0);
                accO = __builtin_amdgcn_mfma_f32_16x16x32_bf16(ai1, *(const LAS bf16x8*)(L + SC_VT + SW128(ct * 16 + lr, (32 + 8 * lq) * 2)), accO, 0, 0, 0);
                const unsigned o01 = cvtpk_c(accO[0] + ei[0] * accQ[0], accO[1] + ei[1] * accQ[1]), o23 = cvtpk_c(accO[2] + ei[2] * accQ[2], accO[3] + ei[3] * accQ[3]);
                LAS unsigned short* ob = (LAS unsigned short*)(L + SC_OB) + i0 * 32 + ct * 16 + lr;
                ob[0] = (unsigned short)(o01 & 0xffffu); ob[32] = (unsigned short)(o01 >> 16); ob[64] = (unsigned short)(o23 & 0xffffu); ob[96] = (unsigned short)(o23 >> 16); }
            if (cc + 1 < 64 && !PVX(2)) SC_PRODUCE_WU(kb ^ 1);
            if (!PVX(7)) {
                const float egl = sc[192]; const unsigned Kb = Lb + SC_K0 + kb * 16384;
                const s16x4_t k0 = tr_rd(Kb + SW256(8 * lq + tq, (w * 16 + 4 * tp) * 2)), k1 = tr_rd(Kb + SW256(8 * lq + 4 + tq, (w * 16 + 4 * tp) * 2));
                const s16x4_t k2 = tr_rd(Kb + SW256(32 + 8 * lq + tq, (w * 16 + 4 * tp) * 2)), k3 = tr_rd(Kb + SW256(32 + 8 * lq + 4 + tq, (w * 16 + 4 * tp) * 2));
                const bf16x8 ka = cat4(k0, k1), kbb = cat4(k2, k3);
#pragma unroll
                for (int c2 = 0; c2 < 2; ++c2) { accS[c2] = accS[c2] * egl;
                    accS[c2] = __builtin_amdgcn_mfma_f32_16x16x32_bf16(ka, *(const LAS bf16x8*)(L + SC_VST + SW128(c2 * 16 + lr, (8 * lq) * 2)), accS[c2], 0, 0, 0);
                    accS[c2] = __builtin_amdgcn_mfma_f32_16x16x32_bf16(kbb, *(const LAS bf16x8*)(L + SC_VST + SW128(c2 * 16 + lr, (32 + 8 * lq) * 2)), accS[c2], 0, 0, 0);
                    v2u pw; pw.x = cvtpk_c(accS[c2][0], accS[c2][1]); pw.y = cvtpk_c(accS[c2][2], accS[c2][3]);
                    *(LAS v2u*)(L + SC_ST + SW256(c2 * 16 + lr, (w * 16 + 4 * lq) * 2)) = pw; } }
            if (!PVX(1)) __syncthreads();
        }
        if (!dry && C.tid < 256) { const size_t grp_ = (size_t)b * SEQ + (size_t)(dir ? 0 : 63) * 64;
            *(GAS v4u*)(odir + ((size_t)dir * NTOK + grp_ + vi) * 1024 + h * 128 + dvs * 32 + vc8) = *(const LAS v4u*)(L + SC_OB + vi * 64 + vc8 * 2); }
#undef SC_LOAD
#undef SC_WRITE
#undef SC_PRODUCE_WU
    }
}

constexpr int N_PHASES = 16;
struct Args { const void* in[24]; float* out; unsigned char* ws; int ph_lo, ph_hi; };
__global__ void __launch_bounds__(NWAVES * 64, 2) fwd(Args args) {
    extern __shared__ __attribute__((aligned(16))) unsigned char lds[];
    Ctx C;
    C.lds = (LAS unsigned char*)lds; C.ws = args.ws; C.out = args.out;
    C.tid = threadIdx.x; C.lane = C.tid & 63; C.wave = __builtin_amdgcn_readfirstlane(C.tid >> 6); C.G = gridDim.x; C.bid = blockIdx.x;
    C.gw = C.bid * NWAVES + C.wave; C.NGW = C.G * NWAVES;
    C.x = (const float*)args.in[0]; C.c = (const float*)args.in[1]; C.positions = (const int*)args.in[2]; C.w_mod = (const float*)args.in[3]; C.b_mod = (const float*)args.in[4];
    C.g_mix = (const float*)args.in[5]; C.w_in = (const float*)args.in[6]; C.conv_w = (const float*)args.in[7]; C.a_log = (const float*)args.in[8]; C.dt_bias = (const float*)args.in[9];
    C.dn_o_gain = (const float*)args.in[10]; C.q_gain = (const float*)args.in[11]; C.w_uq = (const float*)args.in[12]; C.kv_gain = (const float*)args.in[13]; C.w_ukv = (const float*)args.in[14];
    C.w_o_dn = (const float*)args.in[15]; C.w_o_mla = (const float*)args.in[16]; C.w_out = (const float*)args.in[17]; C.g_ffn = (const float*)args.in[18]; C.w_router = (const float*)args.in[19];
    C.w_gate = (const float*)args.in[20]; C.w_up = (const float*)args.in[21]; C.w_down = (const float*)args.in[22]; C.g_final = (const float*)args.in[23];
    unsigned char* ws = args.ws;
    gu32* ctl = (gu32*)(ws + WS_CTL);
    volatile LAS unsigned* MISC = (volatile LAS unsigned*)(C.lds + MISC_OFF);
    for (int u = C.tid; u < (LDS_BYTES - LDSCTL_OFF) / 4; u += NWAVES * 64) ((LAS unsigned*)(C.lds + LDSCTL_OFF))[u] = 0u;
    __syncthreads();
    XcdBarrier bar; bar.bar = (unsigned*)(ctl + CW_BAR); bar.x = 0; bar.st = nullptr;
#if !MK_PER_PHASE
    bar = xcd_barrier_post((unsigned*)(ctl + CW_BAR), MISC + 8);
#endif
    const int lo = args.ph_lo, hi = args.ph_hi & 0xff, p5reps = 1 + ((args.ph_hi >> 8) & 1);
#ifndef PH_MASK
#define PH_MASK 0xFFFFFFFFu
#endif
#define IN(k) (((PH_MASK >> (k)) & 1u) && lo <= (k) && (k) < hi)
#ifndef PROBE_MASK
#define PROBE_MASK 0u
#endif
#define REP(k) (((PROBE_MASK >> (k)) & 1u) != 0u)
#define PHASE(k, ...) if (IN(k)) { __VA_ARGS__ if (REP(k) && !((0x637Cu >> (k)) & 1u)) { __syncthreads(); __VA_ARGS__ } }
#define NREP(k) (REP(k) ? 2 : 1)
#if MK_PER_PHASE
#define SEAM(k) do { } while (0)
#else
#define SEAM(k) do { if (IN(k) && IN((k) + 1)) xcd_barrier(bar); } while (0)
#endif
    bf16* const A_ = (bf16*)(ws + WS_A);

    PHASE(0,  p0_prologue(C); ) SEAM(0);
    PHASE(1,  p1_h(C); ) SEAM(1);
    PHASE(2,
        pg8::Gemm g{A_, (const bf16*)(ws + WS_WIN), NTOK, NPROJ, 1024}; pg8::StaticOrder S; S.init(NTOK, NPROJ, C.G, C.bid, NREP(2));
        EpiProj E{(bf16*)(ws + WS_QKV), (bf16*)(ws + WS_Z), (bf16*)(ws + WS_GATES), (bf16*)(ws + WS_CQ), (bf16*)(ws + WS_CKV), (bf16*)(ws + WS_HALO), (bf16*)(ws + WS_KROPE),
                  (float*)(ws + WS_SSQQ), (float*)(ws + WS_SSQKV), (float*)(ws + WS_BETA), (float*)(ws + WS_G), (const float*)(ws + WS_CS), C.a_log, C.dt_bias};
        pg8::gemm_phase<EpiProj, pg8::StaticOrder, true, true>(C.lds, g, S, E);
    ) SEAM(2);
    PHASE(3,
        { pg8::Gemm g{(const bf16*)(ws + WS_CQ), (const bf16*)(ws + WS_WUQ), NTOK, 1536, QL}; pg8::StaticOrder S; S.init(NTOK, 1536, C.G, C.bid, NREP(3));
          EpiQ E{A_, (const float*)(ws + WS_SSQQ), (const float*)(ws + WS_CS)};
          pg8::gemm_phase<EpiQ, pg8::StaticOrder, true, true>(C.lds, g, S, E); }
        { pg8::Gemm g{(const bf16*)(ws + WS_CKV), (const bf16*)(ws + WS_WUKV), NTOK, 2048, KVL}; KvOrder S; S.init(C.G, C.bid, NREP(3));
          EpiKV E{(bf16*)C.out, (const float*)(ws + WS_SSQKV)};
          pg8::gemm_phase<EpiKV, KvOrder, true, true>(C.lds, g, S, E); }
    ) SEAM(3);
    PHASE(4,
        const bf16* Q = A_; const bf16* KV = (const bf16*)C.out; const bf16* KR = (const bf16*)(ws + WS_KROPE); bf16* O = (bf16*)(ws + WS_OMLA);
        const int xcd = C.bid & 7, j = C.bid >> 3;
        if (C.G == 256) {
            for (int i2 = 0; i2 < 2 * NREP(4); ++i2) { const int i = i2 & 1; const int bh = i * 16 + xcd * 2 + (j >> 4), qb = j & 15, b = bh >> 3, h = bh & 7; const size_t r0 = (size_t)b * SEQ;
                att::attn_unit(Q + (r0 + qb * 256) * 1536 + h * QKD, KV + r0 * 2048 + h * 256, KV + r0 * 2048 + h * 256 + 128, KR + r0 * 64, O + (r0 + qb * 256) * 1024 + h * 128, SEQ, (char*)lds, i2 >= 2); }
        } else {
            for (int u = C.bid; u < 512; u += C.G) { const int bh = u >> 4, qb = u & 15, b = bh >> 3, h = bh & 7; const size_t r0 = (size_t)b * SEQ;
                att::attn_unit(Q + (r0 + qb * 256) * 1536 + h * QKD, KV + r0 * 2048 + h * 256, KV + r0 * 2048 + h * 256 + 128, KR + r0 * 64, O + (r0 + qb * 256) * 1024 + h * 128, SEQ, (char*)lds); }
        }
    ) SEAM(4);
    PHASE(5,  p5_chunk(C, p5reps); ) SEAM(5);
    PHASE(6,  p6_scan(C, NREP(6)); ) SEAM(6);
#ifdef PROBE_XBAR
    if (IN(6) && IN(7)) { for (int xb_ = 0; xb_ < PROBE_XBAR; ++xb_) xcd_barrier(bar); }
#endif
    PHASE(7,  p7_dnout(C); ) SEAM(7);
    PHASE(8,
        pg8::Gemm g{(const bf16*)C.out, (const bf16*)(ws + WS_WODN), NTOK, 1024, 1024, nullptr, (const bf16*)(ws + WS_OMLA), (const bf16*)(ws + WS_WOMLA)}; PairOrder S; S.init(NTOK, 1024, C.G, C.bid, NREP(8));
        EpiMixZ E{(bf16*)(ws + WS_Z), (const bf16*)(ws + WS_GATES)};
        pg8::gemm_phase<EpiMixZ, PairOrder, true, true>(C.lds, g, S, E);
    ) SEAM(8);
    PHASE(9,
        pg8::Gemm g{(const bf16*)(ws + WS_Z), (const bf16*)(ws + WS_WOUT), NTOK, 1024, 1024}; pg8::StaticOrder S; S.init(NTOK, 1024, C.G, C.bid, NREP(9));
        EpiOut E{ws, C.x, (const float*)(ws + WS_MOD)};
        pg8::gemm_phase<EpiOut, pg8::StaticOrder, true, true>(C.lds, g, S, E);
    ) SEAM(9);
    int p10var = 0;
    PHASE(10,  p11_h2(C, p10var); p10var = PROBE_VARIANT; ) SEAM(10);
    PHASE(11,  p12_topk(C); ) if (IN(11) && IN(13)) xcd_barrier(bar);
    PHASE(13,
        pg8::Gemm g{(const bf16*)(ws + WS_A), (const bf16*)(ws + WS_WGU), 64 * CAP, 16 * 2048, 1024, (const int*)(ws + WS_IDX)}; MoeOrder S; S.init(8, C.G, C.bid, NREP(13));
        EpiGU E{(bf16*)(ws + WS_HID)};
        pg8::gemm_phase<EpiGU, MoeOrder, true, true, true>(C.lds, g, S, E);
    ) SEAM(13);
    PHASE(14,
        pg8::Gemm g{(const bf16*)(ws + WS_HID), (const bf16*)(ws + WS_WD), 64 * CAP, 16 * 1024, 1024}; MoeOrder S; S.init(4, C.G, C.bid, NREP(14));
        EpiDown E{(bf16*)(ws + WS_YE), (const float*)(ws + WS_GATEW)};
        pg8::gemm_phase<EpiDown, MoeOrder, true, true>(C.lds, g, S, E);
    ) SEAM(14);
    PHASE(15,  p16_final(C); )
#undef IN
#undef SEAM
}

extern "C" void kernel_launch(void* const* d_in, const int* in_sizes, int n_in, void* d_out, int out_size, void* d_ws, size_t ws_size, hipStream_t stream) {
    static int grid = 0;
    if (grid == 0) {
        if (n_in != 24 || out_size != NTOK * DM || ws_size < WS_END) { fprintf(stderr, "kernel_launch: unexpected shapes: n_in %d out %d ws %zu (need %zu)\n", n_in, out_size, ws_size, (size_t)WS_END); grid = -1; return; }
        int dev = 0, cus = 0, per_cu = 0;
        if (hipGetDevice(&dev) != hipSuccess || hipDeviceGetAttribute(&cus, hipDeviceAttributeMultiprocessorCount, dev) != hipSuccess) { grid = -1; return; }
        if (hipFuncSetAttribute((const void*)fwd, hipFuncAttributeMaxDynamicSharedMemorySize, LDS_BYTES) != hipSuccess) { fprintf(stderr, "kernel_launch: hipFuncSetAttribute failed\n"); grid = -1; return; }
        if (hipOccupancyMaxActiveBlocksPerMultiprocessor(&per_cu, (const void*)fwd, NWAVES * 64, LDS_BYTES) != hipSuccess || per_cu < 1) fprintf(stderr, "kernel_launch: occupancy query reports %d\n", per_cu);
        (void)hipGetLastError();
        grid = cus;
    }
    if (grid < 0) return;
    if (hipMemsetAsync((char*)d_ws + WS_CTL, 0, CTL_ZERO_BYTES, stream) != hipSuccess) return;
    Args a{};
    for (int i = 0; i < 24; ++i) a.in[i] = d_in[i];
    a.out = (float*)d_out; a.ws = (unsigned char*)d_ws;
#if MK_PER_PHASE
    for (int p = 0; p < N_PHASES; ++p) { a.ph_lo = p; a.ph_hi = p + 1; hipLaunchKernelGGL(fwd, dim3(grid), dim3(NWAVES * 64), LDS_BYTES, stream, a); }
#else
    a.ph_lo = 0; a.ph_hi = N_PHASES | (((PROBE_MASK >> 5) & 1u) << 8); hipLaunchKernelGGL(fwd, dim3(grid), dim3(NWAVES * 64), LDS_BYTES, stream, a);
#endif
    const hipError_t le = hipPeekAtLastError();
    if (le != hipSuccess) fprintf(stderr, "kernel_launch: launch failed: %s\n", hipGetErrorName(le));
}
```

```cpp
#include <hip/hip_runtime.h>
#include <cstdio>
#include <cstdint>
#ifndef MK_PER_PHASE
#define MK_PER_PHASE 0
#endif
#ifndef PROBE_MASK
#define PROBE_MASK 0x0u
#endif
#ifndef PROBE_VARIANT
#define PROBE_VARIANT 0x0
#endif
namespace pg8 {
#define PG8_LAS __attribute__((address_space(3)))
typedef unsigned short bf16_t;
typedef short bf16x8 __attribute__((ext_vector_type(8)));
typedef float f32x4 __attribute__((ext_vector_type(4)));
typedef unsigned u32x4 __attribute__((ext_vector_type(4)));
constexpr int BM = 256, BK = 64, HALF = 128, HTB = HALF * BK * 2  , STAGE_BYTES = 8 * HTB, NXCD = 8, WGM = 8;

__host__ __device__ __forceinline__ int lds_byte(int r, int c) { const int st = (r >> 4) * 2 + (c >> 5), rr = r & 15, cc = c & 31, ob = rr * 64 + cc * 2; return st * 1024 + (ob ^ (((ob >> 9) & 1) << 5)); }
__host__ __device__ __forceinline__ void stage_rc(int b, int& R, int& C) { const int st = b / 1024, sb = b % 1024, swz = sb ^ (((sb >> 9) & 1) << 5); R = (st >> 1) * 16 + swz / 64; C = (st & 1) * 32 + (swz % 64) / 2; }
__host__ __device__ __forceinline__ int perm32(int rho) { const int n = rho >> 4, i = rho & 15; return 8 * (i >> 2) + 4 * n + (i & 3); }

struct Unit { int pm, pn, z; };
struct Gemm { const bf16_t* A; const bf16_t* Bt; int M, N, K; const int* arow = nullptr; const bf16_t* A2 = nullptr; const bf16_t* Bt2 = nullptr; };

struct StaticOrder {
    int nM, nN, nwg, G, c, reps;
    __host__ __device__ void init(int M, int N, int G_, int c_, int reps_ = 1) { nM = M / BM; nN = N / BM; nwg = nM * nN; G = G_; c = c_; reps = reps_; }
    __host__ __device__ bool next(int i, Unit& u) const {
        if (reps > 1) { const int per = (nwg - c + G - 1) / G; if (i >= per * reps) return false; i %= per; }
        const long L = (long)i * G + c; if (L >= nwg) return false;
        int wgid = (int)L; { const int q = nwg / NXCD, r = nwg % NXCD, xcd = wgid % NXCD, off = wgid / NXCD; wgid = (xcd < r ? xcd * (q + 1) : r * (q + 1) + (xcd - r) * q) + off; }
        const int nig = WGM * nN, gid = wgid / nig, fm = gid * WGM, gsz = (nM - fm) < WGM ? (nM - fm) : WGM;
        u.pm = fm + ((wgid % nig) % gsz); u.pn = (wgid % nig) / gsz; u.z = 0; return true;
    }
    __device__ __forceinline__ void a_ready(const Unit&) const {}
    __device__ __forceinline__ void done(const Unit&) const {}
};

typedef float f32x2 __attribute__((ext_vector_type(2)));
typedef __bf16 bf16x2_c __attribute__((ext_vector_type(2)));
__device__ __forceinline__ unsigned cvt_pk_bf16(float lo, float hi) { f32x2 v = {lo, hi}; bf16x2_c b2 = __builtin_convertvector(v, bf16x2_c); return __builtin_bit_cast(unsigned, b2); }
template <class Epi, class Sched, bool ALIGN_EPI = false, bool SP2 = false, bool GATHER = false>
__device__ __forceinline__ void gemm_phase(PG8_LAS unsigned char* lds, const Gemm g, const Sched& S, const Epi& E) {
    const int tid = threadIdx.x, wid = __builtin_amdgcn_readfirstlane(tid >> 6), lane = tid & 63, wr = wid >> 2, wc = wid & 3, fr = lane & 15, fq = lane >> 4;
    const int K = g.K, nt = K / BK;
    unsigned voffA[2], voffB[2];
#pragma unroll
    for (int i = 0; i < 2; ++i) { int R, C; stage_rc(tid * 16 + i * 8192, R, C); const int Rb = Epi::PERM ? ((R & ~31) + perm32(R & 31)) : R;
        voffA[i] = (unsigned)(R * K + C) * 2u; voffB[i] = (unsigned)(Rb * K + C) * 2u; }
    const size_t kstep = (size_t)(BK * 2);
    const size_t hstep = (size_t)HALF * K * 2;
    const size_t tstep = 2 * hstep;
    const unsigned ldsw = (unsigned)wid * 1024u;
    const int aoff = lds_byte(wr * 64 + fr, fq * 8), boff = lds_byte(wc * 32 + fr, fq * 8);
#define PG8_SA(b, h) (((b) * 2 + (h)) * HTB)
#define PG8_SB(b, h) ((4 + (b) * 2 + (h)) * HTB)
#define PG8_STAGE(bufoff, gbase, voff) do { _Pragma("unroll") for (int _i = 0; _i < 2; ++_i) \
        __builtin_amdgcn_global_load_lds((const unsigned*)((const char*)(gbase) + (voff)[_i]), (PG8_LAS unsigned*)(lds + (bufoff) + ldsw + _i * 8192), 16, 0, 0); } while (0)
#define PG8_LDA(dst, b, h) do { _Pragma("unroll") for (int m = 0; m < 4; ++m) _Pragma("unroll") for (int k = 0; k < 2; ++k) dst[m][k] = *(const PG8_LAS bf16x8*)(lds + PG8_SA(b, h) + aoff + m * 2048 + k * 1024); } while (0)
#define PG8_LDB(dst, b, h) do { _Pragma("unroll") for (int n = 0; n < 2; ++n) _Pragma("unroll") for (int k = 0; k < 2; ++k) dst[n][k] = *(const PG8_LAS bf16x8*)(lds + PG8_SB(b, h) + boff + n * 2048 + k * 1024); } while (0)
#define PG8_MMA(ai, bj, At, Bt) do { __builtin_amdgcn_s_setprio(1); _Pragma("unroll") for (int m = 0; m < 4; ++m) _Pragma("unroll") for (int n = 0; n < 2; ++n) _Pragma("unroll") for (int k = 0; k < 2; ++k) \
        acc[ai][bj][m][n] = __builtin_amdgcn_mfma_f32_16x16x32_bf16(Bt[n][k], At[m][k], acc[ai][bj][m][n], 0, 0, 0); __builtin_amdgcn_s_setprio(0); } while (0)
#define PG8_WAIT_V(n) asm volatile("s_waitcnt vmcnt(" #n ")" ::: "memory")
#define PG8_WAIT_L(n) asm volatile("s_waitcnt lgkmcnt(" #n ")" ::: "memory")
#define PG8_BAR __builtin_amdgcn_s_barrier()
#define PG8_SCHED __builtin_amdgcn_sched_barrier(0)
    Unit cur, nxt; int ui = 0;
    if (!S.next(0, cur)) return;
    static_assert(!GATHER || SP2, "the gathered-A form exists for the SP2 loop only");
    unsigned vc0[2], vc1[2], vn0[2], vn1[2];
#define PG8_GOFFS(u_, o0_, o1_) do { _Pragma("unroll") for (int i = 0; i < 2; ++i) { int R, C; stage_rc(tid * 16 + i * 8192, R, C); \
        if constexpr (GATHER) { o0_[i] = (unsigned)(g.arow[(u_).pm * BM + R] * K + C) * 2u; o1_[i] = (unsigned)(g.arow[(u_).pm * BM + HALF + R] * K + C) * 2u; } \
        else { o0_[i] = voffA[i]; o1_[i] = voffA[i] + (unsigned)hstep; } } } while (0)
    PG8_GOFFS(cur, vc0, vc1);
#pragma unroll
    for (int i = 0; i < 2; ++i) { vn0[i] = vc0[i]; vn1[i] = vc1[i]; }
    f32x4 acc[2][2][4][2];
#pragma unroll
    for (int a = 0; a < 2; ++a)
#pragma unroll
        for (int b = 0; b < 2; ++b)
#pragma unroll
            for (int m = 0; m < 4; ++m)
#pragma unroll
                for (int n = 0; n < 2; ++n) acc[a][b][m][n] = (f32x4){0.f, 0.f, 0.f, 0.f};
    bf16x8 At[4][2], B0[2][2], B1[2][2];
    const char* cA = (const char*)(cur.z ? g.A2 : g.A) + (GATHER ? (size_t)0 : (size_t)cur.pm * tstep); const char* cB = (const char*)(cur.z ? g.Bt2 : g.Bt) + (size_t)cur.pn * tstep;
    S.a_ready(cur);
    if constexpr (SP2) {
        PG8_STAGE(PG8_SB(0, 0), cB, voffB); PG8_STAGE(PG8_SB(0, 1), cB + hstep, voffB); PG8_STAGE(PG8_SA(0, 0), cA, vc0); PG8_STAGE(PG8_SA(0, 1), cA, vc1);
        if (wr == 1) PG8_BAR;
        PG8_WAIT_V(2); PG8_BAR;
        PG8_STAGE(PG8_SB(1, 0), cB + kstep, voffB); PG8_STAGE(PG8_SA(1, 0), cA + kstep, vc0); PG8_STAGE(PG8_SB(1, 1), cB + hstep + kstep, voffB);
        PG8_WAIT_V(6); PG8_BAR;
    } else {
        PG8_STAGE(PG8_SB(0, 0), cB, voffB); PG8_STAGE(PG8_SA(0, 0), cA, voffA); PG8_STAGE(PG8_SB(0, 1), cB + hstep, voffB); PG8_STAGE(PG8_SA(0, 1), cA + hstep, voffA);
        if (wr == 1) PG8_BAR;
        PG8_WAIT_V(4); PG8_BAR;
        PG8_STAGE(PG8_SB(1, 0), cB + kstep, voffB); PG8_STAGE(PG8_SA(1, 0), cA + kstep, voffA); PG8_STAGE(PG8_SB(1, 1), cB + hstep + kstep, voffB);
        PG8_WAIT_V(6); PG8_BAR;
    }
    for (;;) {
        const bool has_next = S.next(ui + 1, nxt);
        const char* nA = has_next ? (const char*)(nxt.z ? g.A2 : g.A) + (GATHER ? (size_t)0 : (size_t)nxt.pm * tstep) : cA; const char* nB = has_next ? (const char*)(nxt.z ? g.Bt2 : g.Bt) + (size_t)nxt.pn * tstep : cB;
        if constexpr (GATHER) { if (has_next) PG8_GOFFS(nxt, vn0, vn1); }
        asm volatile(".p2align 6\n\ts_nop 0\n\ts_nop 0\n\ts_nop 0\n\ts_nop 0\n\ts_nop 0\n\ts_nop 0\n\ts_nop 0\n\ts_nop 0");
        for (int t = 0; t < nt; t += 2) {
            const bool last = (t == nt - 2);
            const char* a1 = cA + (size_t)(t + 1) * kstep;
            const char* a2 = last ? nA : cA + (size_t)(t + 2) * kstep; const char* b2 = last ? nB : cB + (size_t)(t + 2) * kstep;
            const char* a3 = a2 + kstep; const char* b3 = b2 + kstep;
            if (last && has_next) S.a_ready(nxt);
            if constexpr (SP2) {
            PG8_LDB(B0, 0, 0); PG8_LDB(B1, 0, 1); PG8_SCHED; PG8_LDA(At, 0, 0); PG8_STAGE(PG8_SA(1, 1), a1, vc1);
            PG8_WAIT_V(8); PG8_WAIT_L(0); PG8_BAR; PG8_MMA(0, 0, At, B0); PG8_MMA(0, 1, At, B1); PG8_BAR; PG8_SCHED;
            PG8_LDA(At, 0, 1); PG8_STAGE(PG8_SB(0, 0), b2, voffB); PG8_STAGE(PG8_SB(0, 1), b2 + hstep, voffB); { const unsigned vs_[2] = {last ? vn0[0] : vc0[0], last ? vn0[1] : vc0[1]}; PG8_STAGE(PG8_SA(0, 0), a2, vs_); }
            PG8_WAIT_V(8); PG8_WAIT_L(0); PG8_BAR; PG8_MMA(1, 0, At, B0); PG8_MMA(1, 1, At, B1); PG8_BAR; PG8_SCHED;
            PG8_LDB(B0, 1, 0); PG8_LDB(B1, 1, 1); PG8_SCHED; PG8_LDA(At, 1, 0); { const unsigned vs_[2] = {last ? vn1[0] : vc1[0], last ? vn1[1] : vc1[1]}; PG8_STAGE(PG8_SA(0, 1), a2, vs_); }
            PG8_WAIT_V(8); PG8_WAIT_L(0); PG8_BAR; PG8_MMA(0, 0, At, B0); PG8_MMA(0, 1, At, B1); PG8_BAR; PG8_SCHED;
            PG8_LDA(At, 1, 1); PG8_STAGE(PG8_SB(1, 0), b3, voffB); PG8_STAGE(PG8_SB(1, 1), b3 + hstep, voffB); { const unsigned vs_[2] = {last ? vn0[0] : vc0[0], last ? vn0[1] : vc0[1]}; PG8_STAGE(PG8_SA(1, 0), a3, vs_); }
            PG8_WAIT_V(8); PG8_WAIT_L(0); PG8_BAR; PG8_MMA(1, 0, At, B0); PG8_MMA(1, 1, At, B1); PG8_BAR; PG8_SCHED;
            } else {
            PG8_LDB(B0, 0, 0); PG8_SCHED; PG8_LDA(At, 0, 0); PG8_STAGE(PG8_SA(1, 1), a1 + hstep, voffA);
            PG8_WAIT_L(8); PG8_BAR; PG8_WAIT_L(0); PG8_MMA(0, 0, At, B0); PG8_BAR; PG8_SCHED;
            PG8_LDB(B1, 0, 1); PG8_STAGE(PG8_SB(0, 0), b2, voffB);
            PG8_BAR; PG8_WAIT_L(0); PG8_MMA(0, 1, At, B1); PG8_BAR;
            PG8_LDA(At, 0, 1); PG8_STAGE(PG8_SA(0, 0), a2, voffA);
            PG8_BAR; PG8_WAIT_L(0); PG8_MMA(1, 0, At, B0); PG8_BAR; PG8_SCHED;
            PG8_STAGE(PG8_SB(0, 1), b2 + hstep, voffB);
            PG8_WAIT_V(6); PG8_BAR; PG8_MMA(1, 1, At, B1); PG8_BAR;
            PG8_LDB(B0, 1, 0); PG8_SCHED; PG8_LDA(At, 1, 0); PG8_STAGE(PG8_SA(0, 1), a2 + hstep, voffA);
            PG8_WAIT_L(8); PG8_BAR; PG8_WAIT_L(0); PG8_MMA(0, 0, At, B0); PG8_BAR; PG8_SCHED;
            PG8_LDB(B1, 1, 1); PG8_STAGE(PG8_SB(1, 0), b3, voffB);
            PG8_BAR; PG8_WAIT_L(0); PG8_MMA(0, 1, At, B1); PG8_BAR;
            PG8_LDA(At, 1, 1); PG8_STAGE(PG8_SA(1, 0), a3, voffA);
            PG8_BAR; PG8_WAIT_L(0); PG8_MMA(1, 0, At, B0); PG8_BAR; PG8_SCHED;
            PG8_STAGE(PG8_SB(1, 1), b3 + hstep, voffB);
            PG8_WAIT_V(6); PG8_BAR; PG8_MMA(1, 1, At, B1); PG8_BAR;
            }
        }
        if constexpr (ALIGN_EPI) { if (wr == 0) PG8_BAR; }
        if constexpr (!Epi::AFTER_DRAIN) { E(acc, cur, wr, wc, fr, fq); S.done(cur); }
        if (!has_next) break;
#pragma unroll
        for (int a = 0; a < 2; ++a)
#pragma unroll
            for (int b = 0; b < 2; ++b)
#pragma unroll
                for (int m = 0; m < 4; ++m)
#pragma unroll
                    for (int n = 0; n < 2; ++n) acc[a][b][m][n] = (f32x4){0.f, 0.f, 0.f, 0.f};
        cur = nxt; cA = nA; cB = nB; ++ui;
#pragma unroll
        for (int i = 0; i < 2; ++i) { vc0[i] = vn0[i]; vc1[i] = vn1[i]; }
        if constexpr (ALIGN_EPI) { if (wr == 1) PG8_BAR; }
    }
    PG8_WAIT_V(0);
    if constexpr (!ALIGN_EPI) { if (wr == 0) PG8_BAR; }
    PG8_BAR;
    if constexpr (Epi::AFTER_DRAIN) { E.fused(acc, cur, wr, wc, fr, fq, lds, wid, lane); S.done(cur); }
#undef PG8_SA
#undef PG8_SB
#undef PG8_STAGE
#undef PG8_LDA
#undef PG8_LDB
#undef PG8_MMA
#undef PG8_WAIT_V
#undef PG8_WAIT_L
#undef PG8_BAR
#undef PG8_SCHED
#undef PG8_GOFFS
}
}

#define GAS __attribute__((address_space(1)))
#define LAS __attribute__((address_space(3)))
typedef unsigned short bf16;
typedef unsigned v4u __attribute__((ext_vector_type(4)));
typedef unsigned v2u __attribute__((ext_vector_type(2)));
typedef float f32x4 __attribute__((ext_vector_type(4)));
typedef float f32x2 __attribute__((ext_vector_type(2)));
typedef short bf16x8 __attribute__((ext_vector_type(8)));
typedef GAS unsigned gu32;
#define RLX_AGENT __ATOMIC_RELAXED, __HIP_MEMORY_SCOPE_AGENT
#define LDS_WAIT() asm volatile("s_waitcnt lgkmcnt(0)" ::: "memory")
#define VM_WAIT() asm volatile("s_waitcnt vmcnt(0)" ::: "memory")
__device__ __forceinline__ unsigned f2bf(float f) { unsigned u = __builtin_bit_cast(unsigned, f); return (u + 0x7fffu + ((u >> 16) & 1u)) >> 16; }
typedef __bf16 bf16x2_t __attribute__((ext_vector_type(2)));
__device__ __forceinline__ unsigned cvtpk_c(float lo, float hi) { f32x2 v = {lo, hi}; bf16x2_t b2 = __builtin_convertvector(v, bf16x2_t); return __builtin_bit_cast(unsigned, b2); }
__device__ __forceinline__ unsigned pk2(float lo, float hi) { return cvtpk_c(lo, hi); }
__device__ __forceinline__ float bf2f(unsigned v) { return __builtin_bit_cast(float, v << 16); }
__device__ __forceinline__ float bflo(unsigned w) { return __builtin_bit_cast(float, w << 16); }
__device__ __forceinline__ float bfhi(unsigned w) { return __builtin_bit_cast(float, w & 0xffff0000u); }
__device__ __forceinline__ float sigmoidf_(float x) { return __builtin_amdgcn_rcpf(1.f + __expf(-x)); }
__device__ __forceinline__ float siluf_(float x) { return x * __builtin_amdgcn_rcpf(1.f + __expf(-x)); }
__device__ __forceinline__ float wave_sum(float v) {
#pragma unroll
    for (int o = 1; o < 64; o <<= 1) v += __shfl_xor(v, o);
    return v;
}
#define XB_TMO      128
#define XB_XCNT(j)  (256  + 64 * (j))
#define XB_XSUB(j)  (1280 + 64 * (j))
#define XB_XGEN(j)  (2304 + 64 * (j))
#define XB_TOP      3328
#define XB_TOPGEN   3392
#define XCD_BAR_WORDS 3456
#define XB_SPIN_CAP (1u << 18)

__device__ __forceinline__ unsigned xb_ld(unsigned* p)              { return __hip_atomic_load(p, __ATOMIC_RELAXED, __HIP_MEMORY_SCOPE_AGENT); }
__device__ __forceinline__ unsigned xb_add(unsigned* p, unsigned v) { return __hip_atomic_fetch_add(p, v, __ATOMIC_RELAXED, __HIP_MEMORY_SCOPE_AGENT); }
__device__ __forceinline__ unsigned xb_xcc_id() { return (unsigned)__builtin_amdgcn_s_getreg((3 << 11) | 20) & 0xFu; }
#define XB_SPIN(cond, bar) do { unsigned _sp = 0; while (cond) { __builtin_amdgcn_s_sleep(1); \
    if ((++_sp & 255u) == 0u) { if (xb_ld(&(bar)[XB_TMO])) break; if (_sp > XB_SPIN_CAP) { atomicAdd(&(bar)[XB_TMO], 1u); break; } } } } while (0)

struct XcdBarrier {
    unsigned* bar; unsigned x;
    volatile LAS unsigned* st;
};

__device__ __forceinline__ XcdBarrier xcd_barrier_post(unsigned* bar, volatile LAS unsigned* st) {
    XcdBarrier b; b.bar = bar; b.x = xb_xcc_id(); b.st = st;
    if (threadIdx.x == 0) (void)xb_add(&bar[XB_XCNT(b.x)], 1u);
    return b;
}
__device__ __forceinline__ void xcd_barrier_complete(unsigned* bar, unsigned x, unsigned& nloc, unsigned& nx) {
    const unsigned G = gridDim.x * gridDim.y * gridDim.z;
    unsigned sum, cnt, mine, sp = 0u;
    for (;;) {
        sum = 0u; cnt = 0u; mine = 0u;
#pragma unroll
        for (unsigned j = 0; j < 16; ++j) { const unsigned c = xb_ld(&bar[XB_XCNT(j)]); sum += c; cnt += (c > 0u) ? 1u : 0u; mine = (j == x) ? c : mine; }
        if (sum == G) break;
        __builtin_amdgcn_s_sleep(1);
        if ((++sp & 255u) == 0u) { if (xb_ld(&bar[XB_TMO])) break; if (sp > XB_SPIN_CAP) { atomicAdd(&bar[XB_TMO], 1u); break; } }
    }
    nloc = mine > 0u ? mine : 1u; nx = cnt > 0u ? cnt : 1u;
}

__device__ __forceinline__ void xcd_barrier(const XcdBarrier& b) {
    asm volatile("s_waitcnt vmcnt(0)" ::: "memory");
    __syncthreads();
    if (threadIdx.x == 0) {
        unsigned* bar = b.bar;
        __builtin_amdgcn_s_waitcnt(0);
        unsigned nloc = b.st[0], nx = b.st[1];
        if (nloc == 0u) { xcd_barrier_complete(bar, b.x, nloc, nx); b.st[0] = nloc; b.st[1] = nx; }
        const unsigned old = xb_add(&bar[XB_XSUB(b.x)], 1u);
        const unsigned gen = old / nloc;
        if (old + 1u == (gen + 1u) * nloc) {
            __builtin_amdgcn_fence(__ATOMIC_RELEASE, "agent");
            asm volatile("s_waitcnt vmcnt(0)" ::: "memory");
            const unsigned og = xb_add(&bar[XB_TOP], 1u);
            const unsigned tg = og / nx;
            if (og + 1u == (tg + 1u) * nx) xb_add(&bar[XB_TOPGEN], 1u);
            else XB_SPIN(xb_ld(&bar[XB_TOPGEN]) == tg, bar);
            __builtin_amdgcn_fence(__ATOMIC_ACQUIRE, "agent");
            xb_add(&bar[XB_XGEN(b.x)], 1u);
            asm volatile("s_waitcnt vmcnt(0)" ::: "memory");
        } else {
            XB_SPIN(xb_ld(&bar[XB_XGEN(b.x)]) == gen, bar);
            __builtin_amdgcn_fence(__ATOMIC_ACQUIRE, "agent");
            asm volatile("s_waitcnt vmcnt(0)" ::: "memory");
        }
    }
    __syncthreads();
}

constexpr int NB = 4, SEQ = 4096, DM = 1024, NTOK = NB * SEQ;
constexpr int DNH = 8, DHD = 128;
constexpr int MH = 8, QL = 512, KVL = 256, QKD = 192, NOPE = 128;
constexpr int NE = 16, CAP = 512;
constexpr int NPROJ = 7168;
constexpr float EPS = 1e-6f;
constexpr float QSCALE = 0.07216878364870322f * 1.4426950408889634f;
constexpr int NWAVES = 8;

constexpr size_t MiB = 1u << 20;
constexpr size_t WS_CTL = 0, CTL_ZERO_BYTES = 32 * 1024;
constexpr size_t WS_MOD = 1 * MiB;
constexpr size_t WS_IDX = 1 * MiB + 256 * 1024;
constexpr size_t WS_GATEW = 1 * MiB + 512 * 1024;
constexpr size_t WS_ZROW = 1 * MiB + 768 * 1024;
constexpr size_t WS_CS = 2 * MiB;
constexpr size_t WS_BETA = 6 * MiB;
constexpr size_t WS_G = 7 * MiB;
constexpr size_t WS_SSQQ = 8 * MiB;
constexpr size_t WS_SSQKV = 8 * MiB + 512 * 1024;
constexpr size_t WS_KROPE = 9 * MiB;
constexpr size_t WS_GC = 11 * MiB;
constexpr size_t WS_AFF = 12 * MiB;
constexpr size_t WS_SLOT = 13 * MiB;
constexpr size_t WS_WODN = 14 * MiB, WS_WOMLA = 16 * MiB, WS_WOUT = 18 * MiB;
constexpr size_t WS_WIN = 20 * MiB;
constexpr size_t WS_WUQ = 34 * MiB;
constexpr size_t WS_WUKV = 35 * MiB + 512 * 1024;
constexpr size_t WS_ODIR = 20 * MiB;
constexpr size_t WS_A = 37 * MiB;
constexpr size_t WS_QKV = 85 * MiB;
constexpr size_t WS_XE = 85 * MiB, WS_YE = 85 * MiB;
constexpr size_t WS_HID = 149 * MiB;
constexpr size_t WS_Z = 181 * MiB;
constexpr size_t WS_GATES = 213 * MiB;
constexpr size_t WS_WGU = 213 * MiB;
constexpr size_t WS_CQ = 277 * MiB;
constexpr size_t WS_CKV = 293 * MiB;
constexpr size_t WS_OMLA = 277 * MiB;
constexpr size_t WS_WD = 277 * MiB;
constexpr size_t WS_HALO = 309 * MiB;
constexpr size_t WS_CB = 315 * MiB;
constexpr size_t WS_BT = 316 * MiB;
constexpr size_t WS_X1A = 20 * MiB;
constexpr size_t WS_X1B = 69 * MiB;
constexpr size_t WS_END = 317 * MiB;
constexpr int CW_TMO = 0, CW_CODE = 1, CW_BAR = 4096;

constexpr int RING_BYTES = 131072;
constexpr int LDSCTL_OFF = 155648, MISC_OFF = LDSCTL_OFF + 320;
constexpr int LDS_BYTES = 156672;

typedef pg8::Unit Unit;
typedef const f32x4 (&AccRef)[2][2][4][2];
__device__ __forceinline__ v4u pack8(const f32x4 a, const f32x4 b) { v4u w; w.x = pg8::cvt_pk_bf16(a[0], a[1]); w.y = pg8::cvt_pk_bf16(a[2], a[3]); w.z = pg8::cvt_pk_bf16(b[0], b[1]); w.w = pg8::cvt_pk_bf16(b[2], b[3]); return w; }
__device__ __forceinline__ float softplusf_(float x) { return fmaxf(x, 0.f) + log1pf(__expf(-fabsf(x))); }

__device__ __forceinline__ void rope8(f32x4& a, f32x4& b, const float* csrow) {
    const f32x4 c0 = *(const f32x4*)(csrow), c1 = *(const f32x4*)(csrow + 4);
    f32x4 oa, ob;
    oa[0] = a[0] * c0[0] - a[1] * c0[1]; oa[1] = a[1] * c0[0] + a[0] * c0[1];
    oa[2] = a[2] * c0[2] - a[3] * c0[3]; oa[3] = a[3] * c0[2] + a[2] * c0[3];
    ob[0] = b[0] * c1[0] - b[1] * c1[1]; ob[1] = b[1] * c1[0] + b[0] * c1[1];
    ob[2] = b[2] * c1[2] - b[3] * c1[3]; ob[3] = b[3] * c1[2] + b[2] * c1[3];
    a = oa; b = ob;
}

struct EpiProj {
    static constexpr bool PERM = true, AFTER_DRAIN = false;
    bf16 *qkv, *z, *gates, *cq, *ckv, *halo, *krope; float *ssq_q, *ssq_kv, *beta, *g; const float *cs, *a_log, *dt_bias;
    __device__ __forceinline__ void operator()(AccRef acc, const Unit& u, int wr, int wc, int fr, int fq) const {
        const int pn = u.pn, rbase = u.pm * 256 + wr * 64 + fr, cin = wc * 32 + 8 * fq;
        if (pn < 12) {
#pragma unroll
            for (int ai = 0; ai < 2; ++ai)
#pragma unroll
                for (int m = 0; m < 4; ++m) { const int row = rbase + ai * 128 + m * 16, t64 = row & 63;
                    const bool hl = (t64 < 2) || (t64 >= 62); const int hidx = (row >> 6) * 4 + (t64 < 2 ? t64 : t64 - 60);
#pragma unroll
                    for (int bj = 0; bj < 2; ++bj) { const int col = pn * 256 + bj * 128 + cin; const v4u w = pack8(acc[ai][bj][m][0], acc[ai][bj][m][1]);
                        *(v4u*)(qkv + (size_t)row * 3072 + col) = w; if (hl) *(v4u*)(halo + (size_t)hidx * 3072 + col) = w; } }
        } else if (pn < 16) {
#pragma unroll
            for (int ai = 0; ai < 2; ++ai)
#pragma unroll
                for (int m = 0; m < 4; ++m) { const int row = rbase + ai * 128 + m * 16;
#pragma unroll
                    for (int bj = 0; bj < 2; ++bj) { const int col = (pn - 12) * 256 + bj * 128 + cin; *(v4u*)(z + (size_t)row * 1024 + col) = pack8(acc[ai][bj][m][0], acc[ai][bj][m][1]); } }
        } else if (pn < 24) {
#pragma unroll
            for (int ai = 0; ai < 2; ++ai)
#pragma unroll
                for (int m = 0; m < 4; ++m) { const int row = rbase + ai * 128 + m * 16;
#pragma unroll
                    for (int bj = 0; bj < 2; ++bj) { const int col = (pn - 16) * 256 + bj * 128 + cin; f32x4 a = acc[ai][bj][m][0], b = acc[ai][bj][m][1];
#pragma unroll
                        for (int e = 0; e < 4; ++e) { a[e] = sigmoidf_(a[e]); b[e] = sigmoidf_(b[e]); }
                        *(v4u*)(gates + (size_t)row * 2048 + col) = pack8(a, b); } }
        } else if (pn < 27) {
            const bool isq = pn < 26; bf16* dst = isq ? cq : ckv; const int pitch = isq ? 512 : 256, cb = isq ? (pn - 24) * 256 : 0;
#pragma unroll
            for (int ai = 0; ai < 2; ++ai)
#pragma unroll
                for (int m = 0; m < 4; ++m) { const int row = rbase + ai * 128 + m * 16; float s = 0.f;
#pragma unroll
                    for (int bj = 0; bj < 2; ++bj) { const f32x4 a = acc[ai][bj][m][0], b = acc[ai][bj][m][1];
                        s += (a[0] * a[0] + a[1] * a[1]) + (a[2] * a[2] + a[3] * a[3]) + (b[0] * b[0] + b[1] * b[1]) + (b[2] * b[2] + b[3] * b[3]);
                        *(v4u*)(dst + (size_t)row * pitch + cb + bj * 128 + cin) = pack8(a, b); }
                    s += __shfl_xor(s, 16); s += __shfl_xor(s, 32);
                    if (fq == 0) { if (isq) ssq_q[row * 8 + (pn - 24) * 4 + wc] = s; else ssq_kv[row * 4 + wc] = s; } }
        } else {
#pragma unroll
            for (int ai = 0; ai < 2; ++ai)
#pragma unroll
                for (int m = 0; m < 4; ++m) { const int row = rbase + ai * 128 + m * 16; f32x4 a = acc[ai][0][m][0], b = acc[ai][0][m][1];
                    if (wc < 2) { rope8(a, b, cs + ((size_t)row * 32 + cin / 2) * 2); *(v4u*)(krope + (size_t)row * 64 + cin) = pack8(a, b); }
                    else if (wc == 2) {
                        if (fq < 2) { f32x4 oa, ob;
#pragma unroll
                            for (int e = 0; e < 4; ++e) { oa[e] = sigmoidf_(a[e]); ob[e] = sigmoidf_(b[e]); }
                            *(f32x4*)(beta + (size_t)row * 16 + 8 * fq) = oa; *(f32x4*)(beta + (size_t)row * 16 + 8 * fq + 4) = ob; }
                        else { const int j0 = 8 * (fq - 2); f32x4 oa, ob;
#pragma unroll
                            for (int e = 0; e < 4; ++e) { oa[e] = -__expf(a_log[j0 + e]) * softplusf_(a[e] + dt_bias[j0 + e]); ob[e] = -__expf(a_log[j0 + 4 + e]) * softplusf_(b[e] + dt_bias[j0 + 4 + e]); }
                            *(f32x4*)(g + (size_t)row * 16 + j0) = oa; *(f32x4*)(g + (size_t)row * 16 + j0 + 4) = ob; } } }
        }
    }
};

struct EpiQ {
    static constexpr bool PERM = true, AFTER_DRAIN = false;
    bf16* q; const float *ssq, *cs;
    __device__ __forceinline__ void operator()(AccRef acc, const Unit& u, int wr, int wc, int fr, int fq) const {
        const int rbase = u.pm * 256 + wr * 64 + fr, cin = wc * 32 + 8 * fq;
#pragma unroll
        for (int ai = 0; ai < 2; ++ai)
#pragma unroll
            for (int m = 0; m < 4; ++m) { const int row = rbase + ai * 128 + m * 16;
                const f32x4 s0 = *(const f32x4*)(ssq + (size_t)row * 8), s1 = *(const f32x4*)(ssq + (size_t)row * 8 + 4);
                const float r = rsqrtf(((s0[0] + s0[1]) + (s0[2] + s0[3]) + (s1[0] + s1[1]) + (s1[2] + s1[3])) * (1.f / QL) + EPS) * QSCALE;
#pragma unroll
                for (int bj = 0; bj < 2; ++bj) { const int col = u.pn * 256 + bj * 128 + cin, off = col % QKD; f32x4 a = acc[ai][bj][m][0] * r, b = acc[ai][bj][m][1] * r;
                    if (off >= NOPE) rope8(a, b, cs + ((size_t)row * 32 + (off - NOPE) / 2) * 2);
                    *(v4u*)(q + (size_t)row * 1536 + col) = pack8(a, b); } }
    }
};
struct EpiKV {
    static constexpr bool PERM = true, AFTER_DRAIN = false;
    bf16* kv; const float* ssq;
    __device__ __forceinline__ void operator()(AccRef acc, const Unit& u, int wr, int wc, int fr, int fq) const {
        const int rbase = u.pm * 256 + wr * 64 + fr, cin = wc * 32 + 8 * fq;
#pragma unroll
        for (int ai = 0; ai < 2; ++ai)
#pragma unroll
            for (int m = 0; m < 4; ++m) { const int row = rbase + ai * 128 + m * 16;
                const f32x4 s0 = *(const f32x4*)(ssq + (size_t)row * 4);
                const float r = rsqrtf(((s0[0] + s0[1]) + (s0[2] + s0[3])) * (1.f / KVL) + EPS);
#pragma unroll
                for (int bj = 0; bj < 2; ++bj) { const int col = u.pn * 256 + bj * 128 + cin;
                    *(v4u*)(kv + (size_t)row * 2048 + col) = pack8(acc[ai][bj][m][0] * r, acc[ai][bj][m][1] * r); } }
    }
};
__device__ __forceinline__ void unpack8(const v4u w, f32x4& a, f32x4& b) { a[0] = bflo(w.x); a[1] = bfhi(w.x); a[2] = bflo(w.y); a[3] = bfhi(w.y); b[0] = bflo(w.z); b[1] = bfhi(w.z); b[2] = bflo(w.w); b[3] = bfhi(w.w); }
template <int MODE>
struct EpiMix {
    static constexpr bool PERM = true, AFTER_DRAIN = false;
    bf16* y; const bf16* gates;
    __device__ __forceinline__ void operator()(AccRef acc, const Unit& u, int wr, int wc, int fr, int fq) const {
        const int rbase = u.pm * 256 + wr * 64 + fr, cin = wc * 32 + 8 * fq;
#pragma unroll
        for (int bj = 0; bj < 2; ++bj) { const int col = u.pn * 256 + bj * 128 + cin;
#pragma unroll
            for (int ai = 0; ai < 2; ++ai) { v4u gv[4], yv[4];
#pragma unroll
                for (int m = 0; m < 4; ++m) { const int row = rbase + ai * 128 + m * 16; gv[m] = *(const v4u*)(gates + (size_t)row * 2048 + MODE * 1024 + col);
                    if (MODE == 1) yv[m] = *(const v4u*)(y + (size_t)row * 1024 + col); }
                asm volatile("" ::: "memory");
#pragma unroll
                for (int m = 0; m < 4; ++m) { const int row = rbase + ai * 128 + m * 16;
                    f32x4 ga, gb; unpack8(gv[m], ga, gb);
                    f32x4 a = acc[ai][bj][m][0] * ga, b = acc[ai][bj][m][1] * gb;
                    if (MODE == 1) { f32x4 ya, yb; unpack8(yv[m], ya, yb); a = a + ya; b = b + yb; }
                    *(v4u*)(y + (size_t)row * 1024 + col) = pack8(a, b); }
                asm volatile("" ::: "memory"); }
        }
    }
};
struct EpiOut {
    static constexpr bool PERM = true, AFTER_DRAIN = false;
    unsigned char* ws; const float *x, *mod;
    __device__ __forceinline__ void operator()(AccRef acc, const Unit& u, int wr, int wc, int fr, int fq) const {
        const int rbase = u.pm * 256 + wr * 64 + fr, cin = wc * 32 + 8 * fq; const int b = (u.pm * 256) / SEQ;
        bf16* x1 = (u.pm < 32) ? (bf16*)(ws + WS_X1A) : (bf16*)(ws + WS_X1B) - (size_t)8192 * 1024;
#pragma unroll
        for (int bj = 0; bj < 2; ++bj) { const int col = u.pn * 256 + bj * 128 + cin;
            const f32x4 g0 = *(const f32x4*)(mod + b * 6144 + 2048 + col), g1 = *(const f32x4*)(mod + b * 6144 + 2048 + col + 4);
#pragma unroll
            for (int ai = 0; ai < 2; ++ai) { f32x4 xv[4][2];
#pragma unroll
                for (int m = 0; m < 4; ++m) { const size_t o = (size_t)(rbase + ai * 128 + m * 16) * 1024 + col; xv[m][0] = *(const f32x4*)(x + o); xv[m][1] = *(const f32x4*)(x + o + 4); }
                asm volatile("" ::: "memory");
#pragma unroll
                for (int m = 0; m < 4; ++m) { const size_t o = (size_t)(rbase + ai * 128 + m * 16) * 1024 + col;
                    *(v4u*)(x1 + o) = pack8(xv[m][0] + g0 * acc[ai][bj][m][0], xv[m][1] + g1 * acc[ai][bj][m][1]); }
                asm volatile("" ::: "memory"); } }
    }
};
struct EpiGU {
    static constexpr bool PERM = true, AFTER_DRAIN = false;
    bf16* hid;
    __device__ __forceinline__ void operator()(AccRef acc, const Unit& u, int wr, int wc, int fr, int fq) const {
        const int rbase = u.pm * 256 + wr * 64 + fr, hc = (u.pn & 7) * 128 + wc * 32 + 8 * fq;
#pragma unroll
        for (int ai = 0; ai < 2; ++ai)
#pragma unroll
            for (int m = 0; m < 4; ++m) { const int row = rbase + ai * 128 + m * 16; f32x4 a, b;
#pragma unroll
                for (int k = 0; k < 4; ++k) { a[k] = siluf_(acc[ai][0][m][0][k]) * acc[ai][1][m][0][k]; b[k] = siluf_(acc[ai][0][m][1][k]) * acc[ai][1][m][1][k]; }
                *(v4u*)(hid + (size_t)row * 1024 + hc) = pack8(a, b); }
    }
};
struct EpiDown {
    static constexpr bool PERM = true, AFTER_DRAIN = false;
    bf16* ye; const float* gatew;
    __device__ __forceinline__ void operator()(AccRef acc, const Unit& u, int wr, int wc, int fr, int fq) const {
        const int rbase = u.pm * 256 + wr * 64 + fr, cin = wc * 32 + 8 * fq;
        float gws[2][4];
#pragma unroll
        for (int ai = 0; ai < 2; ++ai)
#pragma unroll
            for (int m = 0; m < 4; ++m) gws[ai][m] = gatew[rbase + ai * 128 + m * 16];
        asm volatile("" ::: "memory");
#pragma unroll
        for (int ai = 0; ai < 2; ++ai)
#pragma unroll
            for (int m = 0; m < 4; ++m) { const int row = rbase + ai * 128 + m * 16; const float gw = gws[ai][m];
#pragma unroll
                for (int bj = 0; bj < 2; ++bj) { const int col = (u.pn & 3) * 256 + bj * 128 + cin;
                    *(v4u*)(ye + (size_t)row * 1024 + col) = pack8(acc[ai][bj][m][0] * gw, acc[ai][bj][m][1] * gw); } }
    }
};
struct MoeOrder {
    int nwg, G, c, ntn, reps;
    __device__ void init(int ntn_, int G_, int c_, int reps_ = 1) { ntn = ntn_; nwg = 64 * 2 * ntn_; G = G_; c = c_; reps = reps_; }
    __device__ bool next(int i, Unit& u) const { if (reps > 1) { const int per = (nwg - c + G - 1) / G; if (i >= per * reps) return false; i %= per; }
        const int L = i * G + c; if (L >= nwg) return false;
        int nt, mh, be;
        if (G == 256) {
            const int x = c & 7, j = c >> 3, per_round = 128 / ntn;
            nt = j % ntn; mh = (j / ntn) & 1; be = i * per_round + (j / (2 * ntn)) * 8 + x;
        } else { nt = L % ntn; mh = (L / ntn) & 1; be = L / (2 * ntn); }
        u.pm = be * 2 + mh; u.pn = (be & 15) * ntn + nt; u.z = 0; return true; }
    __device__ __forceinline__ void a_ready(const Unit&) const {}
    __device__ __forceinline__ void done(const Unit&) const {}
};

struct KvOrder {
    int G, c, reps;
    __device__ void init(int G_, int c_, int reps_ = 1) { G = G_; c = c_; reps = reps_; }
    __device__ bool next(int i, Unit& u) const { int L;
        if (G == 256) { const int per = (c < 128) ? 1 : 3; if (i >= per * reps) return false; i %= per; L = (c < 128) ? c : 128 + (c - 128) * 3 + i; }
        else { const int per = (512 - c + G - 1) / G; if (i >= per * reps) return false; i %= per; L = i * G + c; }
        u.pm = L >> 3; u.pn = L & 7; u.z = 0; return true; }
    __device__ __forceinline__ void a_ready(const Unit&) const {}
    __device__ __forceinline__ void done(const Unit&) const {}
};

struct EpiMixZ {
    static constexpr bool PERM = true, AFTER_DRAIN = false;
    bf16* y; const bf16* gates;
    __device__ __forceinline__ void operator()(AccRef acc, const Unit& u, int wr, int wc, int fr, int fq) const {
        if (u.z == 0) { EpiMix<0> E{y, gates}; E(acc, u, wr, wc, fr, fq); } else { EpiMix<1> E{y, gates}; E(acc, u, wr, wc, fr, fq); }
    }
};
struct PairOrder {
    pg8::StaticOrder S; int reps;
    __device__ void init(int M, int N, int G_, int c_, int reps_ = 1) { S.init(M, N, G_, c_); reps = reps_; }
    __device__ bool next(int i, Unit& u) const { const int per = (S.nwg - S.c + S.G - 1) / S.G; if (i >= 2 * per * reps) return false; i %= 2 * per; const bool ok = S.next(i >> 1, u); u.z = i & 1; return ok; }
    __device__ __forceinline__ void a_ready(const Unit&) const {}
    __device__ __forceinline__ void done(const Unit&) const {}
};

namespace att {
using bf16x8 = __attribute__((ext_vector_type(8))) short;
using s16x4  = __attribute__((ext_vector_type(4))) short;
using f32x16 = __attribute__((ext_vector_type(16))) float;
using u32x4  = __attribute__((ext_vector_type(4))) unsigned;
constexpr int KVBLK = 64;
constexpr int SHM_V = 16384, SHM_KN = 16384, SHM_KR = 8192;
constexpr int OFF_V = 0, OFF_KN = 2 * SHM_V, OFF_KR = OFF_KN + 2 * SHM_KN, OFF_WS = OFF_KR + 2 * SHM_KR, OFF_QR = OFF_WS + 8 * 64 * 4, ATT_LDS = OFF_QR + 8 * 4096;
constexpr float THR2 = 8.f * 1.4426950408889634f;
#define KSWZ(row, colB) ((row) * 256 + ((colB) ^ (((row) & 7) << 4)))
#define KRSWZ(row, colB) ((row) * 128 + ((colB) ^ ((((row) >> 1) & 7) << 4)))
#define SBAR() __builtin_amdgcn_sched_barrier(0)
__device__ __forceinline__ int crow(int r, int hi) { return (r & 3) + 8 * (r >> 2) + 4 * hi; }
__device__ __forceinline__ unsigned cvtpk(float lo, float hi) { return cvtpk_c(lo, hi); }
__device__ __forceinline__ void partialSM(f32x16& p0, f32x16& p1, float& m_reg, float& mn, float& alpha) {
  float pmax = p0[0];
#pragma unroll
  for (int r = 1; r < 16; ++r) pmax = fmaxf(pmax, p0[r]);
#pragma unroll
  for (int r = 0; r < 16; ++r) pmax = fmaxf(pmax, p1[r]);
  { auto rr = __builtin_amdgcn_permlane32_swap(__float_as_uint(pmax), __float_as_uint(pmax), false, false);
    pmax = fmaxf(__uint_as_float(rr[0]), __uint_as_float(rr[1])); }
  if (__builtin_expect(__all(pmax - m_reg <= THR2), 1)) { mn = m_reg; alpha = 1.f; }
  else { mn = fmaxf(m_reg, pmax); alpha = __builtin_amdgcn_exp2f(m_reg - mn); m_reg = mn; }
#pragma unroll
  for (int r = 0; r < 16; ++r) p0[r] = p0[r] - mn;
#pragma unroll
  for (int r = 0; r < 16; ++r) p1[r] = p1[r] - mn;
#pragma unroll
  for (int r = 0; r < 16; ++r) p0[r] = __builtin_amdgcn_exp2f(p0[r]);
}
__device__ __forceinline__ void finishSM(f32x16& p0, f32x16& p1, float alpha, float& l_reg, bf16x8& pa0, bf16x8& pa1, bf16x8& pa2, bf16x8& pa3) {
#pragma unroll
  for (int r = 0; r < 16; ++r) p1[r] = __builtin_amdgcn_exp2f(p1[r]);
  float ps = 0;
#pragma unroll
  for (int r = 0; r < 16; ++r) ps += p0[r];
#pragma unroll
  for (int r = 0; r < 16; ++r) ps += p1[r];
  { auto rr = __builtin_amdgcn_permlane32_swap(__float_as_uint(ps), __float_as_uint(ps), false, false);
    ps = __uint_as_float(rr[0]) + __uint_as_float(rr[1]); }
  l_reg = l_reg * alpha + ps;
#define PK4(P, BASE, OUT) do { unsigned a0 = cvtpk(P[BASE + 0], P[BASE + 1]), a1 = cvtpk(P[BASE + 2], P[BASE + 3]);   \
    unsigned b0 = cvtpk(P[BASE + 4], P[BASE + 5]), b1 = cvtpk(P[BASE + 6], P[BASE + 7]);                              \
    auto r0 = __builtin_amdgcn_permlane32_swap(a0, b0, false, false); auto r1 = __builtin_amdgcn_permlane32_swap(a1, b1, false, false); \
    u32x4 w = {r0[0], r1[0], r0[1], r1[1]}; OUT = __builtin_bit_cast(bf16x8, w); } while (0)
  PK4(p0, 0, pa0); PK4(p0, 8, pa1); PK4(p1, 0, pa2); PK4(p1, 8, pa3);
#undef PK4
}
__device__ __forceinline__ void qkt(f32x16& p0, f32x16& p1, const char* Kn, const char* Kr, const bf16x8* qr, const char* qrl, int r32, int hi) {
  p0 = f32x16{}; p1 = f32x16{};
#pragma unroll
  for (int d0 = 0; d0 < 8; ++d0) { const int cb = (d0 * 16 + hi * 8) * 2;
    bf16x8 b0 = *reinterpret_cast<const bf16x8*>(Kn + KSWZ(r32, cb));
    bf16x8 b1 = *reinterpret_cast<const bf16x8*>(Kn + KSWZ(32 + r32, cb));
    p0 = __builtin_amdgcn_mfma_f32_32x32x16_bf16(b0, qr[d0], p0, 0, 0, 0);
    p1 = __builtin_amdgcn_mfma_f32_32x32x16_bf16(b1, qr[d0], p1, 0, 0, 0); }
#pragma unroll
  for (int d0 = 0; d0 < 4; ++d0) { const int cb = (d0 * 16 + hi * 8) * 2;
    bf16x8 b0 = *reinterpret_cast<const bf16x8*>(Kr + KRSWZ(r32, cb));
    bf16x8 b1 = *reinterpret_cast<const bf16x8*>(Kr + KRSWZ(32 + r32, cb));
    const bf16x8 qf = *reinterpret_cast<const bf16x8*>(qrl + d0 * 1024);
    p0 = __builtin_amdgcn_mfma_f32_32x32x16_bf16(b0, qf, p0, 0, 0, 0);
    p1 = __builtin_amdgcn_mfma_f32_32x32x16_bf16(b1, qf, p1, 0, 0, 0); }
}
__device__ __forceinline__ int v_st(int k, int c) { const int kk = (k & ~0xC) | ((k & 4) << 1) | ((k & 8) >> 1); return ((kk >> 3) * 4 + (c >> 5)) * 512 + ((kk & 7) * 32 + (c & 31)) * 2; }
__device__ __forceinline__ int v_rd_base(int lane) { return ((lane & 3) << 3) | (((lane >> 2) & 3) << 6) | (((lane >> 4) & 1) << 5) | (((lane >> 5) & 1) << 8); }
constexpr int v_rd_off(int d0, int ks, int half) { return d0 * 512 + ks * 4096 + half * 2048; }
template <int OFF> __device__ __forceinline__ s16x4 tr_read(int vb) {
  s16x4 r; asm volatile("ds_read_b64_tr_b16 %0, %1 offset:%2" : "=&v"(r) : "v"(vb), "i"(OFF) : "memory"); return r;
}
template <int D0> __device__ __forceinline__ void pv_one(f32x16& od, int vb, bf16x8 pa0, bf16x8 pa1, bf16x8 pa2, bf16x8 pa3) {
  const s16x4 l0 = tr_read<v_rd_off(D0, 0, 0)>(vb), h0 = tr_read<v_rd_off(D0, 0, 1)>(vb), l1 = tr_read<v_rd_off(D0, 1, 0)>(vb), h1 = tr_read<v_rd_off(D0, 1, 1)>(vb);
  const s16x4 l2 = tr_read<v_rd_off(D0, 2, 0)>(vb), h2 = tr_read<v_rd_off(D0, 2, 1)>(vb), l3 = tr_read<v_rd_off(D0, 3, 0)>(vb), h3 = tr_read<v_rd_off(D0, 3, 1)>(vb);
  asm volatile("s_waitcnt lgkmcnt(0)" ::: "memory"); SBAR();
#define PK(L, H) (bf16x8){L[0], L[1], L[2], L[3], H[0], H[1], H[2], H[3]}
  od = __builtin_amdgcn_mfma_f32_32x32x16_bf16(pa0, PK(l0, h0), od, 0, 0, 0);
  od = __builtin_amdgcn_mfma_f32_32x32x16_bf16(pa1, PK(l1, h1), od, 0, 0, 0);
  od = __builtin_amdgcn_mfma_f32_32x32x16_bf16(pa2, PK(l2, h2), od, 0, 0, 0);
  od = __builtin_amdgcn_mfma_f32_32x32x16_bf16(pa3, PK(l3, h3), od, 0, 0, 0);
#undef PK
}
__device__ __forceinline__ void pv_d0(f32x16* o, int vb, bf16x8 pa0, bf16x8 pa1, bf16x8 pa2, bf16x8 pa3) {
  pv_one<0>(o[0], vb, pa0, pa1, pa2, pa3); pv_one<1>(o[1], vb, pa0, pa1, pa2, pa3); pv_one<2>(o[2], vb, pa0, pa1, pa2, pa3); pv_one<3>(o[3], vb, pa0, pa1, pa2, pa3);
}
__device__ __forceinline__ void attn_unit(const unsigned short* __restrict__ Qb, const unsigned short* __restrict__ Kn, const unsigned short* __restrict__ Vh, const unsigned short* __restrict__ Kr,
                                          unsigned short* __restrict__ Ob, int seq, char* lds, bool dry = false) {
#ifndef PROBE_VARIANT
#define PROBE_VARIANT 0
#endif
#define PVA(bit) (dry && ((PROBE_VARIANT >> (bit)) & 1))
  const int tid = threadIdx.x, wid = tid >> 6, lane = tid & 63, r32 = lane & 31, hi = lane >> 5;
  char* V_lds = lds + OFF_V; char* KN_lds = lds + OFF_KN; char* KR_lds = lds + OFF_KR;
  float* ws = (float*)(lds + OFF_WS) + wid * 64; float* li_l = ws; float* al_l = ws + 32;
  float m_reg = -1e30f, l_reg = 0; f32x16 o[4] = {}; bf16x8 qr[8];
  const unsigned short* Qw = Qb + (long)(wid * 32 + r32) * 1536 + hi * 8;
  char* qrl = lds + OFF_QR + wid * 4096 + lane * 16;
#pragma unroll
  for (int d0 = 0; d0 < 8; ++d0) qr[d0] = *reinterpret_cast<const bf16x8*>(Qw + d0 * 16);
#pragma unroll
  for (int d0 = 0; d0 < 4; ++d0) *reinterpret_cast<bf16x8*>(qrl + d0 * 1024) = *reinterpret_cast<const bf16x8*>(Qw + (8 + d0) * 16);
  const int sr = tid >> 4, sc = (tid & 15) * 8, vst0 = v_st(sr, sc), vst1 = v_st(32 + sr, sc);
  const int rr_ = tid >> 3, rc_ = (tid & 7) * 8;
  const int vb0 = (int)(uintptr_t)V_lds + v_rd_base(lane);
  bf16x8 vs0, vs1, ks0, ks1, kr0;
  const unsigned kvoff = (unsigned)(sr * 2048 + sc) * 2u, kroff = (unsigned)(rr_ * 64 + rc_) * 2u;
#define SLOAD(k0) do { const char* kb_ = (const char*)Kn + (size_t)(k0) * 4096; const char* vb_ = (const char*)Vh + (size_t)(k0) * 4096; const char* rb_ = (const char*)Kr + (size_t)(k0) * 128; \
    vs0 = *reinterpret_cast<const bf16x8*>(vb_ + kvoff); vs1 = *reinterpret_cast<const bf16x8*>(vb_ + 131072 + kvoff); \
    ks0 = *reinterpret_cast<const bf16x8*>(kb_ + kvoff); ks1 = *reinterpret_cast<const bf16x8*>(kb_ + 131072 + kvoff); \
    kr0 = *reinterpret_cast<const bf16x8*>(rb_ + kroff); } while (0)
#define SWRITE(b) do { *(bf16x8*)(V_lds + (b) * SHM_V + vst0) = vs0; *(bf16x8*)(V_lds + (b) * SHM_V + vst1) = vs1; const int kc = sc * 2; \
    *(bf16x8*)(KN_lds + (b) * SHM_KN + KSWZ(sr, kc)) = ks0; *(bf16x8*)(KN_lds + (b) * SHM_KN + KSWZ(32 + sr, kc)) = ks1; \
    *(bf16x8*)(KR_lds + (b) * SHM_KR + KRSWZ(rr_, rc_ * 2)) = kr0; } while (0)
#define SWAIT() asm volatile("s_waitcnt vmcnt(0)" ::: "memory")
#define RESC(a) do { if (__any((a) < 1.f)) { if (hi == 0) al_l[r32] = (a); asm volatile("s_waitcnt lgkmcnt(0)" ::: "memory"); \
    _Pragma("unroll") for (int d = 0; d < 4; ++d) _Pragma("unroll") for (int r = 0; r < 16; ++r) o[d][r] *= al_l[crow(r, hi)]; } } while (0)
  f32x16 pA0, pA1, pB0, pB1; float mnA, mnB, alA, alB; bf16x8 pa0, pa1, pa2, pa3; const int NT = seq / KVBLK;
  SLOAD(0); SWAIT(); SWRITE(0); __syncthreads();
  qkt(pA0, pA1, KN_lds, KR_lds, qr, qrl, r32, hi); partialSM(pA0, pA1, m_reg, mnA, alA);
  SLOAD(KVBLK); SWAIT(); SWRITE(1); __syncthreads();
  asm volatile(".p2align 6\n\ts_nop 0\n\ts_nop 0\n\ts_nop 0\n\ts_nop 0\n\ts_nop 0\n\ts_nop 0\n\ts_nop 0\n\ts_nop 0");
  for (int j = 1; j + 1 < NT; j += 2) {
    SBAR(); qkt(pB0, pB1, KN_lds + SHM_KN, KR_lds + SHM_KR, qr, qrl, r32, hi);
    if (!PVA(13)) finishSM(pA0, pA1, alA, l_reg, pa0, pa1, pa2, pa3); SBAR();
    if (!PVA(12)) SLOAD((j + 1) * KVBLK); SBAR();
    pv_d0(o, vb0, pa0, pa1, pa2, pa3); if (!PVA(13)) partialSM(pB0, pB1, m_reg, mnB, alB);
    if (!PVA(14)) __syncthreads(); if (!PVA(12)) { SWAIT(); SWRITE(0); }
    RESC(alB); if (!PVA(14)) __syncthreads();
    SBAR(); qkt(pA0, pA1, KN_lds, KR_lds, qr, qrl, r32, hi);
    if (!PVA(13)) finishSM(pB0, pB1, alB, l_reg, pa0, pa1, pa2, pa3); SBAR();
    if (!PVA(12)) SLOAD((j + 2) * KVBLK); SBAR();
    pv_d0(o, vb0 + SHM_V, pa0, pa1, pa2, pa3); if (!PVA(13)) partialSM(pA0, pA1, m_reg, mnA, alA);
    if (!PVA(14)) __syncthreads(); if (!PVA(12)) { SWAIT(); SWRITE(1); }
    RESC(alA); if (!PVA(14)) __syncthreads();
  }
  SBAR(); qkt(pB0, pB1, KN_lds + SHM_KN, KR_lds + SHM_KR, qr, qrl, r32, hi);
  finishSM(pA0, pA1, alA, l_reg, pa0, pa1, pa2, pa3); SBAR();
  pv_d0(o, vb0, pa0, pa1, pa2, pa3); partialSM(pB0, pB1, m_reg, mnB, alB);
  __syncthreads(); RESC(alB);
  finishSM(pB0, pB1, alB, l_reg, pa0, pa1, pa2, pa3); SBAR();
  pv_d0(o, vb0 + SHM_V, pa0, pa1, pa2, pa3);
  if (hi == 0) li_l[r32] = l_reg; asm volatile("s_waitcnt lgkmcnt(0)" ::: "memory");
  float rli[16];
#pragma unroll
  for (int r = 0; r < 16; ++r) rli[r] = __builtin_amdgcn_rcpf(li_l[crow(r, hi)]);
  __syncthreads();
  { char* ost = lds + OFF_V + wid * 8192;
    unsigned obase = (unsigned)(uintptr_t)ost + hi * 1024 + r32 * 2; asm volatile("" : "+v"(obase));
#pragma unroll
    for (int r = 0; r < 16; ++r) {
#pragma unroll
      for (int d0 = 0; d0 < 4; ++d0) *(__attribute__((address_space(3))) unsigned short*)(uintptr_t)(obase + crow(r, 0) * 256 + d0 * 64) = (unsigned short)f2bf(o[d0][r] * rli[r]); }
    asm volatile("s_waitcnt lgkmcnt(0)" ::: "memory");
    unsigned short* Ow = Ob + (long)(wid * 32) * 1024;
    if (!dry) {
      const unsigned gvo = (unsigned)(lane >> 4) * 2048u + (unsigned)(lane & 15) * 16u;
#pragma unroll
      for (int q = 0; q < 8; ++q) *(u32x4*)((char*)Ow + (size_t)q * 8192 + gvo) = *(const u32x4*)(ost + (q * 64 + lane) * 16); } }
  __syncthreads();
#undef SLOAD
#undef SWRITE
#undef SWAIT
#undef RESC
}
#undef KSWZ
#undef KRSWZ
#undef SBAR
}

struct Ctx {
    LAS unsigned char* lds; unsigned char* ws; float* out;
    int tid, lane, wave, G, bid, gw, NGW;
    const float *x, *c, *w_mod, *b_mod, *g_mix, *w_in, *conv_w, *a_log, *dt_bias, *dn_o_gain, *q_gain, *w_uq, *kv_gain, *w_ukv, *w_o_dn, *w_o_mla, *w_out, *g_ffn, *w_router, *w_gate, *w_up, *w_down, *g_final;
    const int* positions;
};

template <class RowMap>
__device__ __forceinline__ void transpose_item(const float* W, int K, int N, bf16* WT, const float* kscale, LAS float* scr, int item, int lane, RowMap rm) {
    const int nblk = N / 32, kb = item / nblk, nb = item % nblk, k0 = 64 * kb, n0 = 32 * nb;
    { float tv[32];
#pragma unroll
      for (int i = 0; i < 32; ++i) { const int kk = 2 * i + (lane >> 5); tv[i] = W[(size_t)(k0 + kk) * N + n0 + (lane & 31)]; }
#pragma unroll
      for (int i = 0; i < 32; ++i) { const int kk = 2 * i + (lane >> 5); float v = tv[i]; if (kscale) v *= kscale[k0 + kk]; scr[kk * 33 + (lane & 31)] = v; } }
    LDS_WAIT(); asm volatile("" ::: "memory");
    const int c = lane & 7;
#pragma unroll
    for (int j = 0; j < 4; ++j) { const int n = (lane >> 3) + 8 * j; const LAS float* s = scr + (8 * c) * 33 + n;
        v4u o; o.x = pk2(s[0 * 33], s[1 * 33]); o.y = pk2(s[2 * 33], s[3 * 33]); o.z = pk2(s[4 * 33], s[5 * 33]); o.w = pk2(s[6 * 33], s[7 * 33]);
        *(GAS v4u*)(WT + (size_t)rm(n0 + n) * K + k0 + 8 * c) = o; }
    LDS_WAIT(); asm volatile("" ::: "memory");
}
__device__ __forceinline__ int win_dest_row(int s) {
    if (s < 4096) return s;
    if (s < 4112) return 6912 + 64 + (s - 4096);
    if (s < 4128) return 6912 + 80 + (s - 4112);
    if (s < 4640) return 6144 + (s - 4128);
    if (s < 4896) return 6656 + (s - 4640);
    if (s < 4960) { const int i = s - 4896; return 6912 + (i < 32 ? 2 * i : 2 * (i - 32) + 1); }
    return 4096 + (s - 4960);
}
__device__ __forceinline__ int wuq_dest_row(int s) { const int h = s / QKD, o = s % QKD; if (o < NOPE) return s; const int i = o - NOPE; return h * QKD + NOPE + (i < 32 ? 2 * i : 2 * (i - 32) + 1); }

__device__ __forceinline__ void p0_prologue(const Ctx& C0) {
    Ctx C = C0; asm volatile("" : "+v"(C.tid)); C.lane = C.tid & 63;
    float* mod = (float*)(C.ws + WS_MOD);
    if (C.bid < 96) {
        LAS float* sc = (LAS float*)C.lds;
        LAS float* red = (LAS float*)(C.lds + 16384);
        for (int i = C.tid; i < 4096; i += 512) sc[i] = siluf_(C.c[i]);
        __syncthreads();
        const int col = C.bid * 64 + C.lane; float a0 = 0.f, a1 = 0.f, a2 = 0.f, a3 = 0.f;
        for (int k0 = C.wave * 128; k0 < C.wave * 128 + 128; k0 += 16) { float wv[16];
#pragma unroll
            for (int i = 0; i < 16; ++i) wv[i] = C.w_mod[(size_t)(k0 + i) * 6144 + col];
#pragma unroll
            for (int i = 0; i < 16; ++i) { const int k = k0 + i; a0 += sc[k] * wv[i]; a1 += sc[1024 + k] * wv[i]; a2 += sc[2048 + k] * wv[i]; a3 += sc[3072 + k] * wv[i]; } }
        red[(C.wave * 4 + 0) * 64 + C.lane] = a0; red[(C.wave * 4 + 1) * 64 + C.lane] = a1; red[(C.wave * 4 + 2) * 64 + C.lane] = a2; red[(C.wave * 4 + 3) * 64 + C.lane] = a3;
        __syncthreads();
        if (C.wave < 4) { float s = C.b_mod[col];
#pragma unroll
            for (int w = 0; w < 8; ++w) s += red[(w * 4 + C.wave) * 64 + C.lane];
            mod[C.wave * 6144 + col] = s; }
        __syncthreads();
    }
    LAS float* scr = (LAS float*)(C.lds + C.wave * 16384);
    constexpr int I_IN = 16 * 219, I_UQ = 8 * 48, I_UKV = 4 * 64, I_SQ = 16 * 32;
    constexpr int NITEMS = I_IN + I_UQ + I_UKV + 3 * I_SQ;
    bf16* win_t = (bf16*)(C.ws + WS_WIN);
    for (int it = C.gw; it < NITEMS; it += C.NGW) {
        int r = it;
        if (r < I_IN) { transpose_item(C.w_in, 1024, 7008, win_t, nullptr, scr, r, C.lane, [](int s) { return win_dest_row(s); }); continue; } r -= I_IN;
        if (r < I_UQ) { transpose_item(C.w_uq, 512, 1536, (bf16*)(C.ws + WS_WUQ), C.q_gain, scr, r, C.lane, [](int s) { return wuq_dest_row(s); }); continue; } r -= I_UQ;
        if (r < I_UKV) { transpose_item(C.w_ukv, 256, 2048, (bf16*)(C.ws + WS_WUKV), C.kv_gain, scr, r, C.lane, [](int s) { return s; }); continue; } r -= I_UKV;
        if (r < I_SQ) { transpose_item(C.w_o_dn, 1024, 1024, (bf16*)(C.ws + WS_WODN), nullptr, scr, r, C.lane, [](int s) { return s; }); continue; } r -= I_SQ;
        if (r < I_SQ) { transpose_item(C.w_o_mla, 1024, 1024, (bf16*)(C.ws + WS_WOMLA), nullptr, scr, r, C.lane, [](int s) { return s; }); continue; } r -= I_SQ;
        transpose_item(C.w_out, 1024, 1024, (bf16*)(C.ws + WS_WOUT), nullptr, scr, r, C.lane, [](int s) { return s; });
    }
    { v4u zz = {0u, 0u, 0u, 0u}; GAS v4u* p = (GAS v4u*)(win_t + (size_t)7008 * 1024);
      for (int i = C.bid * 512 + C.tid; i < 160 * 1024 / 8; i += C.G * 512) p[i] = zz; }
    if (C.bid == 0) for (int i = C.tid; i < 3072 * 2 / 16; i += 512) *(GAS v4u*)(C.ws + WS_ZROW + (size_t)i * 16) = (v4u){0u, 0u, 0u, 0u};
    { float* cs = (float*)(C.ws + WS_CS);
      const float inv_freq = powf(10000.0f, -(float)(C.tid & 31) / 32.0f);
      for (int i = C.bid * 512 + C.tid; i < NTOK * 32; i += C.G * 512) { const int tok = i >> 5;
          const float ang = (float)C.positions[tok] * inv_freq;
          float s, c; sincosf(ang, &s, &c); cs[2 * i] = c; cs[2 * i + 1] = s; } }
}

__device__ __forceinline__ void p1_h(const Ctx& C0) {
    Ctx C = C0; asm volatile("" : "+v"(C.tid)); C.lane = C.tid & 63;
    const float* mod = (const float*)(C.ws + WS_MOD); bf16* h = (bf16*)(C.ws + WS_A);
    for (int m = C.gw; m < NTOK; m += C.NGW) { const int b = m / SEQ;
        const GAS f32x4* xr = (const GAS f32x4*)(C.x + (size_t)m * DM) + C.lane; f32x4 v[4]; float s = 0.f;
#pragma unroll
        for (int j = 0; j < 4; ++j) { v[j] = xr[64 * j]; s += (v[j].x * v[j].x + v[j].y * v[j].y) + (v[j].z * v[j].z + v[j].w * v[j].w); }
        const float rstd = rsqrtf(wave_sum(s) * (1.f / DM) + EPS);
        GAS v2u* o8 = (GAS v2u*)(h + (size_t)m * DM) + C.lane;
#pragma unroll
        for (int j = 0; j < 4; ++j) { const int col = 4 * C.lane + 256 * j;
            const f32x4 gm = *(const f32x4*)(C.g_mix + col), sh = *(const f32x4*)(mod + b * 6144 + col), sc = *(const f32x4*)(mod + b * 6144 + 1024 + col);
            const f32x4 y = v[j] * rstd * gm * (sc + 1.f) + sh; v2u w; w.x = pk2(y.x, y.y); w.y = pk2(y.z, y.w); o8[64 * j] = w; } }
}

__device__ __forceinline__ void p7_dnout(const Ctx& C0) {
    Ctx C = C0; asm volatile("" : "+v"(C.tid)); C.lane = C.tid & 63;
    const bf16* odir = (const bf16*)(C.ws + WS_ODIR); const bf16* z = (const bf16*)(C.ws + WS_Z); bf16* dno = (bf16*)C.out;
    for (int m = C.gw; m < NTOK; m += C.NGW) { const int c0 = C.lane * 16;
        f32x4 f[4], r[4], zz[4];
        { const GAS v4u* p = (const GAS v4u*)(odir + (size_t)m * 1024 + c0); unpack8(p[0], f[0], f[1]); unpack8(p[1], f[2], f[3]); }
        { const GAS v4u* p = (const GAS v4u*)(odir + ((size_t)NTOK + m) * 1024 + c0); unpack8(p[0], r[0], r[1]); unpack8(p[1], r[2], r[3]); }
        { const GAS v4u* p = (const GAS v4u*)(z + (size_t)m * 1024 + c0); unpack8(p[0], zz[0], zz[1]); unpack8(p[1], zz[2], zz[3]); }
        float s = 0.f;
#pragma unroll
        for (int j = 0; j < 4; ++j) { f[j] = f[j] + r[j]; s += (f[j].x * f[j].x + f[j].y * f[j].y) + (f[j].z * f[j].z + f[j].w * f[j].w); }
        s += __shfl_xor(s, 1); s += __shfl_xor(s, 2); s += __shfl_xor(s, 4);
        const float rstd = rsqrtf(s * (1.f / DHD) + EPS);
#pragma unroll
        for (int j = 0; j < 4; ++j) { const f32x4 og = *(const f32x4*)(C.dn_o_gain + (c0 & 127) + 4 * j);
#pragma unroll
            for (int e = 0; e < 4; ++e) f[j][e] = f[j][e] * rstd * og[e] * siluf_(zz[j][e]); }
        GAS v4u* o = (GAS v4u*)(dno + (size_t)m * 1024 + c0); o[0] = pack8(f[0], f[1]); o[1] = pack8(f[2], f[3]); }
}

__device__ __forceinline__ const bf16* x1_row(const unsigned char* ws, int m) { return (m < 8192) ? (const bf16*)(ws + WS_X1A) + (size_t)m * DM : (const bf16*)(ws + WS_X1B) + (size_t)(m - 8192) * DM; }
__device__ __forceinline__ f32x4 unpack4(const v2u w) { f32x4 r; r.x = bflo(w.x); r.y = bfhi(w.x); r.z = bflo(w.y); r.w = bfhi(w.y); return r; }
constexpr int RT_PITCH = 2064, RT_PART = 16 * RT_PITCH, RT_GA = 3 * RT_PART, RT_GB = RT_GA + 4096, RT_HS = RT_GB + 4096, RT_H = RT_HS + 512, RT_XA = RT_H + 128, RT_XS = RT_XA + 8192;
__device__ __forceinline__ void p11_h2(const Ctx& C0, int var = 0) {
    Ctx C = C0; asm volatile("" : "+v"(C.tid)); C.lane = C.tid & 63;
    const float* mod = (const float*)(C.ws + WS_MOD); bf16* h2 = (bf16*)(C.ws + WS_A); float* aff = (float*)(C.ws + WS_AFF);
    LAS unsigned char* L = C.lds; LAS float* GAl = (LAS float*)(L + RT_GA); LAS float* GBl = (LAS float*)(L + RT_GB); LAS float* HS = (LAS float*)(L + RT_HS); LAS float* Hl = (LAS float*)(L + RT_H);
    for (int blk = C.bid; blk < NTOK / 64; blk += C.G) { const int T0 = blk * 64, b = T0 / SEQ;
        int ln_ = C.lane; asm volatile("" : "+v"(ln_));
        const int tl = ln_ & 15, kg = ln_ >> 4, kh = C.wave >> 2, tok = T0 + 16 * (C.wave & 3) + tl;
        const GAS v4u* xr = (const GAS v4u*)(x1_row(C.ws, tok) + 512 * kh + 8 * kg);
        v4u xv[16];
#pragma unroll
        for (int s_ = 0; s_ < 16; ++s_) xv[s_] = xr[4 * s_];
        for (int i = C.tid; i < DM; i += NWAVES * 64) { GAl[i] = C.g_ffn[i] * (mod[b * 6144 + 4096 + i] + 1.f); GBl[i] = mod[b * 6144 + 3072 + i]; }
        __syncthreads();
        { float hp = 0.f; const int e = C.tid & 15;
#pragma unroll 4
          for (int k = 0; k < 16; ++k) { const int cp = (C.tid + 512 * k) >> 4, c0 = 2 * cp; const float w0 = C.w_router[c0 * 16 + e], w1 = C.w_router[c0 * 16 + 16 + e];
              float g0 = GAl[c0] * w0, g1 = GAl[c0 + 1] * w1; hp += GBl[c0] * w0 + GBl[c0 + 1] * w1;
#pragma unroll
              for (int p = 0; p < 3; ++p) { const unsigned pk = pk2(g0, g1); *(LAS unsigned*)(L + p * RT_PART + e * RT_PITCH + c0 * 2) = pk; g0 -= bflo(pk); g1 -= bfhi(pk); } }
          hp += __shfl_xor(hp, 16); hp += __shfl_xor(hp, 32); if (C.lane < 16) HS[C.wave * 16 + C.lane] = hp; }
        __syncthreads();
        if (C.tid < 16) { float h = 0.f;
#pragma unroll
            for (int w = 0; w < NWAVES; ++w) h += HS[w * 16 + C.tid]; Hl[C.tid] = h; }
        f32x4 acc = {0.f, 0.f, 0.f, 0.f}; float ssq = 0.f;
        const LAS unsigned char* gb_ = L + tl * RT_PITCH + 1024 * kh + 16 * kg;
#pragma unroll
        for (int s_ = 0; s_ < 16; ++s_) { const bf16x8 a = __builtin_bit_cast(bf16x8, xv[s_]);
#pragma unroll
            for (int p = 0; p < 3; ++p) acc = __builtin_amdgcn_mfma_f32_16x16x32_bf16(a, *(const LAS bf16x8*)(gb_ + p * RT_PART + 64 * s_), acc, 0, 0, 0);
            const v4u w = xv[s_]; const float x0 = bflo(w.x), x1_ = bfhi(w.x), x2 = bflo(w.y), x3 = bfhi(w.y), x4 = bflo(w.z), x5 = bfhi(w.z), x6 = bflo(w.w), x7 = bfhi(w.w);
            ssq += ((x0 * x0 + x1_ * x1_) + (x2 * x2 + x3 * x3)) + ((x4 * x4 + x5 * x5) + (x6 * x6 + x7 * x7));
            if (s_ & 1) asm volatile("" : "+v"(acc) :: "memory"); }
        ssq += __shfl_xor(ssq, 16); ssq += __shfl_xor(ssq, 32);
        *(LAS f32x4*)(L + RT_XA + (C.wave * 64 + ln_) * 16) = acc; if (kg == 0) *(LAS float*)(L + RT_XS + (C.wave * 16 + tl) * 4) = ssq;
        __syncthreads();
        { const f32x4 pa = *(const LAS f32x4*)(L + RT_XA + ((C.wave ^ 4) * 64 + ln_) * 16); acc = kh ? pa + acc : acc + pa; const float ps = *(const LAS float*)(L + RT_XS + ((C.wave ^ 4) * 16 + tl) * 4); ssq = kh ? ps + ssq : ssq + ps; }
        const float rstd = rsqrtf(ssq * (1.f / DM) + EPS);
        GAS v4u* ho = (GAS v4u*)(h2 + (size_t)tok * DM + 512 * kh + 8 * kg); const LAS unsigned char* gab_ = L + RT_GA + 2048 * kh + 32 * kg;
#pragma unroll
        for (int s_ = 0; s_ < 16; ++s_) { const f32x4 ga0 = *(const LAS f32x4*)(gab_ + 128 * s_), ga1 = *(const LAS f32x4*)(gab_ + 128 * s_ + 16), gb0 = *(const LAS f32x4*)(gab_ + 4096 + 128 * s_), gb1 = *(const LAS f32x4*)(gab_ + 4096 + 128 * s_ + 16);
            v4u w = xv[s_]; asm volatile("" : "+v"(w)); v4u o;
            o.x = pk2(bflo(w.x) * rstd * ga0[0] + gb0[0], bfhi(w.x) * rstd * ga0[1] + gb0[1]); o.y = pk2(bflo(w.y) * rstd * ga0[2] + gb0[2], bfhi(w.y) * rstd * ga0[3] + gb0[3]);
            o.z = pk2(bflo(w.z) * rstd * ga1[0] + gb1[0], bfhi(w.z) * rstd * ga1[1] + gb1[1]); o.w = pk2(bflo(w.w) * rstd * ga1[2] + gb1[2], bfhi(w.w) * rstd * ga1[3] + gb1[3]);
            if (!((var >> 18) & 1)) ho[4 * s_] = o;
            if (s_ & 1) asm volatile("" ::: "memory"); }
        const float he = Hl[tl];
#pragma unroll
        for (int rr = 0; rr < 2; ++rr) { const int r = 2 * kh + rr; const float av = kh ? (rr ? acc[3] : acc[2]) : (rr ? acc[1] : acc[0]);
            const float lgt = av * __shfl(rstd, 4 * kg + r) + he; float mx = lgt;
#pragma unroll
            for (int o = 1; o < 16; o <<= 1) mx = fmaxf(mx, __shfl_xor(mx, o));
            const float ex = __expf(lgt - mx); float den = ex;
#pragma unroll
            for (int o = 1; o < 16; o <<= 1) den += __shfl_xor(den, o);
            if (!((var >> 17) & 1)) aff[(size_t)(T0 + 16 * (C.wave & 3) + 4 * kg + r) * NE + tl] = ex / den; }
        __syncthreads(); }
}

__device__ __forceinline__ void p12_topk(const Ctx& C0) {
    Ctx C = C0; asm volatile("" : "+v"(C.tid)); C.lane = C.tid & 63;
    if (C.bid < NB * NE) {
        const float* aff = (const float*)(C.ws + WS_AFF); int* idx = (int*)(C.ws + WS_IDX) + C.bid * CAP; float* gatew = (float*)(C.ws + WS_GATEW) + C.bid * CAP;
        int* slot = (int*)(C.ws + WS_SLOT) + (size_t)C.bid * SEQ;
        LAS unsigned* hist = (LAS unsigned*)C.lds;
        LAS unsigned* sel = hist + 256;
        LAS unsigned* wsum = hist + 264;
        LAS int* lidx = (LAS int*)(hist + 512);
        unsigned key[8];
        { const GAS unsigned* p = (const GAS unsigned*)aff + ((size_t)(C.bid >> 4) * SEQ + C.tid * 8) * NE + (C.bid & 15);
#pragma unroll
          for (int j = 0; j < 8; ++j) key[j] = p[j * NE]; }
        unsigned prefix = 0u, krem = CAP;
        for (int pass = 0; pass < 4; ++pass) { const int shift = 24 - 8 * pass;
            if (C.tid < 256) hist[C.tid] = 0u;
            __syncthreads();
#pragma unroll
            for (int j = 0; j < 8; ++j) { const bool match = (pass == 0) || ((key[j] >> (shift + 8)) == prefix); if (match) __hip_atomic_fetch_add(&hist[(key[j] >> shift) & 255u], 1u, __ATOMIC_RELAXED, __HIP_MEMORY_SCOPE_WORKGROUP); }
            __syncthreads();
            if (C.wave == 0) { const unsigned c0 = hist[4 * C.lane], c1 = hist[4 * C.lane + 1], c2 = hist[4 * C.lane + 2], c3 = hist[4 * C.lane + 3]; const unsigned s = c0 + c1 + c2 + c3;
                unsigned suf = s;
#pragma unroll
                for (int o = 1; o < 64; o <<= 1) { const unsigned t2 = __shfl_down(suf, o); if (C.lane + o < 64) suf += t2; }
                const unsigned above = suf - s;
                if (above < krem && krem <= suf) { unsigned run = above; int bin;
                    if (run + c3 >= krem) bin = 3; else { run += c3; if (run + c2 >= krem) bin = 2; else { run += c2; if (run + c1 >= krem) bin = 1; else { run += c1; bin = 0; } } }
                    sel[0] = 4 * C.lane + bin; sel[1] = krem - run; } }
            __syncthreads();
            prefix = (prefix << 8) | sel[0]; krem = sel[1];
            __syncthreads();
        }
        unsigned ngt = 0u, neq = 0u;
#pragma unroll
        for (int j = 0; j < 8; ++j) { ngt += key[j] > prefix; neq += key[j] == prefix; }
        unsigned igt = ngt, ieq = neq;
#pragma unroll
        for (int o = 1; o < 64; o <<= 1) { const unsigned a = __shfl_up(igt, o), b2 = __shfl_up(ieq, o); if (C.lane >= o) { igt += a; ieq += b2; } }
        if (C.lane == 63) { wsum[C.wave * 2] = igt; wsum[C.wave * 2 + 1] = ieq; }
        __syncthreads();
        unsigned bgt = igt - ngt, beq = ieq - neq;
        for (int w = 0; w < C.wave; ++w) { bgt += wsum[w * 2]; beq += wsum[w * 2 + 1]; }
#pragma unroll
        for (int j = 0; j < 8; ++j) { const int t = C.tid * 8 + j; int sl = -1;
            if (key[j] > prefix) { sl = (int)(bgt + (beq < krem ? beq : krem)); ++bgt; }
            else if (key[j] == prefix) { if (beq < krem) sl = (int)(bgt + beq); ++beq; }
            slot[t] = sl; if (sl >= 0) { idx[sl] = (C.bid >> 4) * SEQ + t; gatew[sl] = __builtin_bit_cast(float, key[j]); } }
        __syncthreads();
    }
    LAS float* scr = (LAS float*)(C.lds + C.wave * 16384);
    bf16* wgu = (bf16*)(C.ws + WS_WGU); bf16* wd = (bf16*)(C.ws + WS_WD);
    const int nA = (16 * 3 * 512 * 8) / 10  , nB = 16 * 3 * 512 - nA, gwB = (C.bid - NB * NE) * NWAVES + C.wave, ngwB = (C.G - NB * NE) * NWAVES;
    const int cntA = (nA - C.gw + C.NGW - 1) / C.NGW, cntB = (C.bid >= NB * NE && ngwB > 0) ? (nB - gwB + ngwB - 1) / ngwB : 0;
    for (int q = 0; q < cntA + cntB; ++q) { const int it = (q < cntA) ? C.gw + q * C.NGW : nA + gwB + (q - cntA) * ngwB;
        const int e = it / 1536, r = it % 1536, which = r / 512, item = r % 512;
        if (which == 0) transpose_item(C.w_gate + (size_t)e * 1048576, 1024, 1024, wgu + (size_t)e * 2048 * 1024, nullptr, scr, item, C.lane, [](int s) { return 256 * (s >> 7) + (s & 127); });
        else if (which == 1) transpose_item(C.w_up + (size_t)e * 1048576, 1024, 1024, wgu + (size_t)e * 2048 * 1024, nullptr, scr, item, C.lane, [](int s) { return 256 * (s >> 7) + 128 + (s & 127); });
        else transpose_item(C.w_down + (size_t)e * 1048576, 1024, 1024, wd + (size_t)e * 1024 * 1024, nullptr, scr, item, C.lane, [](int s) { return s; }); }
}

__device__ __forceinline__ void p16_final(const Ctx& C0) {
    Ctx C = C0; asm volatile("" : "+v"(C.tid)); C.lane = C.tid & 63;
    const float* mod = (const float*)(C.ws + WS_MOD); const bf16* ye = (const bf16*)(C.ws + WS_YE); const int* slot = (const int*)(C.ws + WS_SLOT);
    typedef int i32x4 __attribute__((ext_vector_type(4)));
    f32x4 gfin[4];
#pragma unroll
    for (int j = 0; j < 4; ++j) gfin[j] = *(const f32x4*)(C.g_final + 4 * C.lane + 256 * j);
    for (int q = C.gw; q < NTOK / 4; q += C.NGW) { const int m0 = 4 * q, b = m0 / SEQ, t0 = m0 % SEQ;
        i32x4 s4 = {-1, -1, -1, -1};
        if (C.lane < NE) s4 = *(const GAS i32x4*)(slot + ((size_t)b * NE + C.lane) * SEQ + t0);
        f32x4 g2[4];
#pragma unroll
        for (int j = 0; j < 4; ++j) g2[j] = *(const f32x4*)(mod + b * 6144 + 5120 + 4 * C.lane + 256 * j);
        v2u xn[4];
        { const GAS v2u* xr0 = (const GAS v2u*)x1_row(C.ws, m0) + C.lane;
#pragma unroll
          for (int j = 0; j < 4; ++j) xn[j] = xr0[64 * j]; }
#pragma unroll
        for (int k = 0; k < 4; ++k) { const int m = m0 + k; const int myslot = s4[k];
            f32x4 v[4];
#pragma unroll
            for (int j = 0; j < 4; ++j) v[j] = unpack4(xn[j]);
            if (k < 3) { const GAS v2u* xr1 = (const GAS v2u*)x1_row(C.ws, m + 1) + C.lane;
#pragma unroll
                for (int j = 0; j < 4; ++j) xn[j] = xr1[64 * j]; }
            f32x4 acc[4];
#pragma unroll
            for (int j = 0; j < 4; ++j) acc[j] = (f32x4){0.f, 0.f, 0.f, 0.f};
            unsigned mask = (unsigned)__ballot(myslot >= 0) & 0xffffu;
            while (mask) { v2u w[4][4];
#pragma unroll
                for (int u = 0; u < 4; ++u) {
                    if (mask) { const int e = __ffs(mask) - 1; mask &= mask - 1u; const int sl = __shfl(myslot, e);
                        const GAS v2u* pp = (const GAS v2u*)(ye + ((size_t)(b * NE + e) * CAP + sl) * DM) + C.lane;
#pragma unroll
                        for (int j = 0; j < 4; ++j) w[u][j] = pp[64 * j]; }
                    else {
#pragma unroll
                        for (int j = 0; j < 4; ++j) w[u][j] = (v2u){0u, 0u}; } }
#pragma unroll
                for (int u = 0; u < 4; ++u)
#pragma unroll
                    for (int j = 0; j < 4; ++j) { acc[j].x += bflo(w[u][j].x); acc[j].y += bfhi(w[u][j].x); acc[j].z += bflo(w[u][j].y); acc[j].w += bfhi(w[u][j].y); } }
            float s = 0.f;
#pragma unroll
            for (int j = 0; j < 4; ++j) { v[j] = v[j] + g2[j] * acc[j]; s += (v[j].x * v[j].x + v[j].y * v[j].y) + (v[j].z * v[j].z + v[j].w * v[j].w); }
            const float rstd = rsqrtf(wave_sum(s) * (1.f / DM) + EPS);
            GAS f32x4* xr = (GAS f32x4*)(C.out + (size_t)m * DM) + C.lane;
#pragma unroll
            for (int j = 0; j < 4; ++j) xr[64 * j] = v[j] * rstd * gfin[j]; } }
}

#define SW128(row, boff) ((row) * 128 + ((boff) ^ ((((row) >> 1) & 7) << 4)))
#define SW256(row, boff) ((row) * 256 + ((boff) ^ (((row) & 15) << 4)))
typedef float f32x16 __attribute__((ext_vector_type(16)));
__device__ __forceinline__ int crow32(int r, int hi) { return (r & 3) + 8 * (r >> 2) + 4 * hi; }

template <int REV>
__device__ __forceinline__ void tri_solve_ip(LAS float* Lm, LAS bf16* Tl, int lane) {
    LAS float* colp = Lm + (REV ? 63 - lane : lane); asm volatile("" : "+v"(colp));
    LAS float* dummy = (LAS float*)Tl + lane;
#pragma unroll
    for (int R = 0; R < 4; ++R) {
        float a[16];
#pragma unroll
        for (int ii = 0; ii < 16; ++ii) a[ii] = 0.f;
        if (R > 0) {
            int l_ = lane; asm volatile("" : "+v"(l_));
            const int i15 = l_ & 15, kq = l_ >> 4, dk = i15 - kq;
            f32x4 d[3] = {{0.f, 0.f, 0.f, 0.f}, {0.f, 0.f, 0.f, 0.f}, {0.f, 0.f, 0.f, 0.f}};
#pragma unroll
            for (int s_ = 0; s_ < 4 * R; ++s_) { const int k = 4 * s_ + kq;
                const float av = -(REV ? Lm[(63 - 16 * R - i15) * 64 + 63 - k] : Lm[(16 * R + i15) * 64 + k]);
#pragma unroll
                for (int t = 0; t < R; ++t) { const int dlt = 4 * s_ - 16 * t;
                    if (dlt + 3 < 0) continue;
                    const int c = 16 * t + i15; float bv = REV ? Lm[(63 - k) * 64 + 63 - c] : Lm[k * 64 + c];
                    if (dlt <= 15) bv = (dk < dlt) ? bv : ((dk == dlt) ? 1.f : 0.f);
                    d[t] = __builtin_amdgcn_mfma_f32_16x16x4f32(av, bv, d[t], 0, 0, 0); } }
            LAS float* stg = (LAS float*)Tl + 256;
#pragma unroll
            for (int t = 0; t < R; ++t)
#pragma unroll
                for (int r = 0; r < 4; ++r) stg[(4 * kq + r) * 64 + 16 * t + i15] = d[t][r];
            asm volatile("s_waitcnt lgkmcnt(0)" ::: "memory");
#pragma unroll
            for (int ii = 0; ii < 16; ++ii) { const float v = stg[ii * 64 + l_]; a[ii] = (l_ < 16 * R) ? v : 0.f; }
            asm volatile("" : "+v"(a[0]), "+v"(a[1]), "+v"(a[2]), "+v"(a[3]), "+v"(a[4]), "+v"(a[5]), "+v"(a[6]), "+v"(a[7]), "+v"(a[8]), "+v"(a[9]), "+v"(a[10]), "+v"(a[11]), "+v"(a[12]), "+v"(a[13]), "+v"(a[14]), "+v"(a[15]) :: "memory");
        }
        f32x4 p2[16][4];
#pragma unroll
        for (int ii = 1; ii < 16; ++ii) { const int il = 16 * R + ii;
#pragma unroll
            for (int q = 0; q < (ii + 3) / 4; ++q) { const int j0 = 16 * R + 4 * q; p2[ii][q] = REV ? *(const LAS f32x4*)(Lm + (63 - il) * 64 + 60 - j0) : *(const LAS f32x4*)(Lm + il * 64 + j0); } }
        float xb[16];
#pragma unroll
        for (int ii = 0; ii < 16; ++ii) { const int il = 16 * R + ii; float acc = a[ii] + ((lane == il) ? 1.f : 0.f), acc2 = 0.f;
#pragma unroll
            for (int q = 0; q < (ii + 3) / 4; ++q) { const f32x4 l4 = p2[ii][q];
                if (4 * q + 0 < ii) acc -= (REV ? l4[3] : l4[0]) * xb[4 * q + 0];
                if (4 * q + 1 < ii) acc2 -= (REV ? l4[2] : l4[1]) * xb[4 * q + 1];
                if (4 * q + 2 < ii) acc -= (REV ? l4[1] : l4[2]) * xb[4 * q + 2];
                if (4 * q + 3 < ii) acc2 -= (REV ? l4[0] : l4[3]) * xb[4 * q + 3]; }
            xb[ii] = acc + acc2; }
        asm volatile("" : "+v"(xb[15]) :: "memory");
#pragma unroll
        for (int ii = 0; ii < 16; ++ii) { const int il = 16 * R + ii; LAS float* wp = (lane < il) ? colp + (REV ? 63 - il : il) * 64 : dummy; *wp = xb[ii]; }
        asm volatile("" : "+v"(lane), "+v"(colp), "+v"(dummy) :: "memory");
    }
    int pc = lane; asm volatile("" : "+v"(pc));
    const LAS float* src = Lm + pc; LAS bf16* dst = Tl + pc;
#pragma unroll
    for (int i = 0; i < 64; ++i) { const float v = src[i * 64]; const bool mine = REV ? (pc > i) : (pc < i); dst[i * 64] = (bf16)f2bf(mine ? v : ((pc == i) ? 1.f : 0.f)); }
}
typedef short s16x4_t __attribute__((ext_vector_type(4)));

constexpr size_t T2_OFF = (size_t)NB * DNH * 64 * 2 * 4096;
constexpr int DN_RAW = 0, DN_KBUF = 53248, DN_LMAT = 69632, DN_GCS = 135168, DN_RNL = 139264;
__device__ __forceinline__ void p5_chunk(const Ctx& C0, int reps) {
    Ctx C = C0; asm volatile("" : "+v"(C.tid)); C.lane = C.tid & 63;
    bf16* qkv = (bf16*)(C.ws + WS_QKV); const bf16* halo = (const bf16*)(C.ws + WS_HALO); const bf16* zrow = (const bf16*)(C.ws + WS_ZROW);
    const float* beta = (const float*)(C.ws + WS_BETA); const float* gg = (const float*)(C.ws + WS_G); float* gcg = (float*)(C.ws + WS_GC); float* cbg = (float*)(C.ws + WS_CB); float* btg = (float*)(C.ws + WS_BT); bf16* Tbuf = (bf16*)C.out;
    LAS unsigned char* raw = C.lds + DN_RAW; LAS unsigned char* kbuf = C.lds + DN_KBUF; LAS float* rnl = (LAS float*)(C.lds + DN_RNL) + C.wave * 32;
    const int nun = (512 * reps - C.bid + C.G - 1) / C.G, nch = nun * 4;
#ifndef PROBE_VARIANT
#define PROBE_VARIANT 0
#endif
#define PV5(bit) (!wr && ((PROBE_VARIANT >> (bit)) & 1))
    v4u pre[7];
#define PRE_LOAD(q_) do { const int u1_ = C.bid + ((q_) >> 2) * C.G, u_ = u1_ & 511, n_ = (u_ & 15) * 4 + ((q_) & 3), h_ = (u_ >> 4) & 7, b_ = u_ >> 7, gch_ = b_ * 64 + n_; const size_t gr0_ = (size_t)b_ * SEQ + n_ * 64; \
        _Pragma("unroll") for (int it = 0; it < 7; ++it) { int idx = C.tid + 512 * it; if (it == 6 && idx >= 68 * 48) idx = 0; const int r = idx / 48, ch = idx % 48, col = (ch >> 4) * 1024 + h_ * 128 + (ch & 15) * 8; \
            const bf16* top = (n_ > 0) ? halo + (size_t)((gch_ - 1) * 4 + 2 + r) * 3072 : zrow; const bf16* bot = (n_ < 63) ? halo + (size_t)((gch_ + 1) * 4 + (r - 66)) * 3072 : zrow; \
            const bf16* mid = qkv + (gr0_ + r - 2) * 3072; const bf16* rowp = (r < 2) ? top : ((r >= 66) ? bot : mid); pre[it] = *(const GAS v4u*)(rowp + col); } } while (0)
    if (nch > 0) PRE_LOAD(0);
    for (int q = 0; q < nch; ++q) {
        const int u1 = C.bid + (q >> 2) * C.G, u = u1 & 511, c = q & 3; const bool wr = u1 < 512;
        const int grp = u & 15, h = (u >> 4) & 7, b = u >> 7, n = grp * 4 + c; const size_t gr0 = (size_t)b * SEQ + n * 64;
        int tid = C.tid; asm volatile("" : "+v"(tid)); const int lane = tid & 63;
        LAS float* gcs = (LAS float*)(C.lds + DN_GCS + c * 1024); LAS float* Lm = (LAS float*)(C.lds + DN_LMAT + c * 16384);
#pragma unroll
        for (int it = 0; it < 7; ++it) { const int idx = tid + 512 * it; if (it < 6 || idx < 68 * 48) { const int r = idx / 48, ch = idx % 48; *(LAS v4u*)(raw + r * 768 + ch * 16) = pre[it]; } }
        if (C.wave == 6) { float s = gg[(gr0 + lane) * 16 + h];
#pragma unroll
            for (int o = 1; o < 64; o <<= 1) { const float t2 = __shfl_up(s, o); if (lane >= o) s += t2; }
            const float bt_ = beta[(gr0 + lane) * 16 + h]; const size_t so_ = ((size_t)(0 * NB + b) * DNH + h) * SEQ + n * 64 + lane; gcs[lane] = s; gcs[128 + lane] = bt_; gcg[so_] = s; cbg[so_] = bt_ * __expf(s); btg[so_] = bt_; }
        if (C.wave == 7) { float s = gg[(gr0 + lane) * 16 + 8 + h];
#pragma unroll
            for (int o = 1; o < 64; o <<= 1) { const float t2 = __shfl_down(s, o); if (lane + o < 64) s += t2; }
            const float bt_ = beta[(gr0 + lane) * 16 + 8 + h]; const size_t so_ = ((size_t)(1 * NB + b) * DNH + h) * SEQ + n * 64 + lane; gcs[64 + lane] = s; gcs[192 + lane] = bt_; gcg[so_] = s; cbg[so_] = bt_ * __expf(s); btg[so_] = bt_; }
        __syncthreads();
        if (q + 1 < nch && !PV5(11)) PRE_LOAD(q + 1);
        if (C.wave < 6 && !PV5(8)) { const int ten = C.wave >> 1, rh = C.wave & 1, gcol = ten * 1024 + h * 128 + 2 * lane;
            float w0[5], w1[5];
#pragma unroll
            for (int k = 0; k < 5; ++k) { w0[k] = C.conv_w[k * 3072 + gcol]; w1[k] = C.conv_w[k * 3072 + gcol + 1]; }
            const LAS unsigned char* rp = raw + ten * 256 + lane * 4 + rh * 32 * 768;
            float y0[32], y1[32];
            { float x0[36], x1[36];
#pragma unroll
              for (int r = 0; r < 36; ++r) { const unsigned w = *(const LAS unsigned*)(rp + r * 768); x0[r] = bflo(w); x1[r] = bfhi(w); }
#pragma unroll
              for (int r = 0; r < 32; ++r) { float a0 = 0.f, a1 = 0.f;
#pragma unroll
                  for (int k = 0; k < 5; ++k) { a0 += w0[k] * x0[r + k]; a1 += w1[k] * x1[r + k]; }
                  y0[r] = siluf_(a0); y1[r] = siluf_(a1); } }
            if (ten < 2) {
                float t[32];
#pragma unroll
                for (int r = 0; r < 32; ++r) t[r] = y0[r] * y0[r] + y1[r] * y1[r];
#pragma unroll
                for (int lv = 0; lv < 5; ++lv) { const int half = 16 >> lv, bit = 32 >> lv; const bool up = (lane & bit) != 0;
#pragma unroll
                    for (int r = 0; r < half; ++r) { float lo_ = t[r], hi_ = t[r + half]; asm volatile("" : "+v"(lo_), "+v"(hi_));
                        const float give = up ? lo_ : hi_, keep = up ? hi_ : lo_; t[r] = keep + __shfl_xor(give, bit); } }
                const float tot = t[0] + __shfl_xor(t[0], 1);
                rnl[(lane >> 1) & 31] = rsqrtf(tot + EPS) * (ten == 0 ? 0.08838834764831845f : 1.f);
                LDS_WAIT();
#pragma unroll
                for (int r4 = 0; r4 < 8; ++r4) { const f32x4 rn = *(const LAS f32x4*)(rnl + 4 * r4);
#pragma unroll
                    for (int e = 0; e < 4; ++e) { y0[4 * r4 + e] *= rn[e]; y1[4 * r4 + e] *= rn[e]; } } }
            unsigned pk[32];
#pragma unroll
            for (int r = 0; r < 32; ++r) pk[r] = cvtpk_c(y0[r], y1[r]);
            if (wr) { bf16* op = qkv + (gr0 + rh * 32) * 3072 + gcol;
#pragma unroll
                for (int r = 0; r < 32; ++r) *(GAS unsigned*)(op + (size_t)r * 3072) = pk[r]; }
            if (ten == 1) {
#pragma unroll
                for (int r = 0; r < 32; ++r) *(LAS unsigned*)(kbuf + SW256(rh * 32 + r, 4 * lane)) = pk[r]; } }
        __syncthreads();
        if (!PV5(9)) {
            const int ti = C.wave >> 1; int lr = lane & 15, lq = lane >> 4; asm volatile("" : "+v"(lr), "+v"(lq));
            bf16x8 ka[4];
#pragma unroll
            for (int ks = 0; ks < 4; ++ks) ka[ks] = *(const LAS bf16x8*)(kbuf + SW256(ti * 16 + lr, (ks * 32 + 8 * lq) * 2));
#pragma unroll
            for (int t2 = 0; t2 < 2; ++t2) { const int tj = 2 * (C.wave & 1) + t2; f32x4 acc = {0.f, 0.f, 0.f, 0.f};
#pragma unroll
                for (int ks = 0; ks < 4; ++ks) acc = __builtin_amdgcn_mfma_f32_16x16x32_bf16(ka[ks], *(const LAS bf16x8*)(kbuf + SW256(tj * 16 + lr, (ks * 32 + 8 * lq) * 2)), acc, 0, 0, 0);
                const int j = tj * 16 + lr; const float gfj = gcs[j], gbj = gcs[64 + j];
#pragma unroll
                for (int r = 0; r < 4; ++r) { const int i = ti * 16 + 4 * lq + r; float val = 0.f;
                    if (i > j) val = gcs[128 + i] * acc[r] * __expf(gcs[i] - gfj);
                    else if (i < j) val = gcs[192 + i] * acc[r] * __expf(gcs[64 + i] - gbj);
                    Lm[i * 64 + j] = val; } } }
        __syncthreads();
        if (c == 3 && !PV5(10)) {
            const int cs = C.wave >> 1, dir = C.wave & 1, ns = grp * 4 + cs; const LAS float* Ls = (const LAS float*)(C.lds + DN_LMAT + cs * 16384);
            bf16* Tg = Tbuf + ((size_t)(((b * DNH + h) * 64 + ns) * 2 + dir)) * 4096;
            LAS bf16* Tl = (LAS bf16*)(C.lds + C.wave * 8192);
            int ln = C.lane; asm volatile("" : "+v"(ln));
            if (dir == 0) tri_solve_ip<0>((LAS float*)Ls, Tl, ln); else tri_solve_ip<1>((LAS float*)Ls, Tl, ln);
            LDS_WAIT();
            const LAS unsigned char* tsrc = (const LAS unsigned char*)Tl + ln * 16; bf16* tdst = Tg + ln * 8;
            if (wr) { _Pragma("unroll") for (int q2 = 0; q2 < 8; ++q2) *(GAS v4u*)(tdst + q2 * 512) = *(const LAS v4u*)(tsrc + q2 * 1024); }
            __syncthreads();
        }
    }
#undef PRE_LOAD
}

constexpr int SC_K0 = 0, SC_Q0 = 32768, SC_T = 65536, SC_T2 = 73728, SC_V = 81920, SC_SC0 = 86016, SC_W = 88064, SC_IT = 104448, SC_UT = 112640, SC_ST = 120832, SC_VT = 129024, SC_VST = 133120, SC_OB = 137216;
typedef short s16x4_t __attribute__((ext_vector_type(4)));
__device__ __forceinline__ s16x4_t tr_rd(unsigned addr) { return __builtin_amdgcn_ds_read_tr16_b64_v4i16((LAS s16x4_t*)(uintptr_t)addr); }
__device__ __forceinline__ bf16x8 cat4(s16x4_t a, s16x4_t b) { return (bf16x8){a[0], a[1], a[2], a[3], b[0], b[1], b[2], b[3]}; }
#define SWU(row, chunk) ((row) * 256 + ((((chunk) ^ (row)) & 15) * 16))
__device__ __forceinline__ void p6_scan(const Ctx& C0, int reps) {
    Ctx C = C0; asm volatile("" : "+v"(C.tid)); C.lane = C.tid & 63;
    const bf16* qkv = (const bf16*)(C.ws + WS_QKV); const float* gcg = (const float*)(C.ws + WS_GC); const float* btg = (const float*)(C.ws + WS_BT); const float* cbg = (const float*)(C.ws + WS_CB);
    const bf16* Tbuf = (const bf16*)C.out; bf16* odir = (bf16*)(C.ws + WS_ODIR);
    LAS unsigned char* L = C.lds; const unsigned Lb = (unsigned)(uintptr_t)L;
    const int w = C.wave, lr = C.lane & 15, lq = C.lane >> 4, tq = lr >> 2, tp = lr & 3, rt = w >> 1, ct = w & 1;
    for (int u1 = C.bid; u1 < 256 * reps; u1 += C.G) { const int u0 = u1 & 255; const bool dry = u1 >= 256;
#define PVX(bit) (dry && ((PROBE_VARIANT >> (bit)) & 1))
        int dvs, seq; if (C.G == 256) { const int xcd = u0 & 7, j = u0 >> 3; dvs = j & 3; seq = (j >> 2) * 8 + xcd; } else { dvs = u0 & 3; seq = u0 >> 2; }
        const int dir = seq & 1, h = (seq >> 1) & 7, b = seq >> 4;
        f32x4 accS[2] = {{0.f, 0.f, 0.f, 0.f}, {0.f, 0.f, 0.f, 0.f}};
        v4u sk0, sk1, sq0, sq1, st0, sv0; f32x4 scb0, scb1; float sgc = 0.f, sbt = 0.f;
        const int ki = C.tid >> 4, kc8 = (C.tid & 15) * 8, ti_ = C.tid >> 3, tc8 = (C.tid & 7) * 8, vi = (C.tid & 255) >> 2, vc8 = (C.tid & 3) * 8;
        const size_t seqoff = ((size_t)(dir * NB + b) * DNH + h) * SEQ;
#define SC_LOAD(n_) do { const size_t gr0_ = (size_t)b * SEQ + (size_t)(n_) * 64; const bf16* kb_ = qkv + gr0_ * 3072 + 1024 + h * 128; const bf16* qb_ = qkv + gr0_ * 3072 + h * 128; \
        const bf16* tb_ = Tbuf + ((size_t)(((b * DNH + h) * 64 + (n_)) * 2 + dir)) * 4096 + ti_ * 64 + tc8; \
        sk0 = *(const GAS v4u*)(kb_ + (size_t)ki * 3072 + kc8); sk1 = *(const GAS v4u*)(kb_ + (size_t)(ki + 32) * 3072 + kc8); \
        sq0 = *(const GAS v4u*)(qb_ + (size_t)ki * 3072 + kc8); sq1 = *(const GAS v4u*)(qb_ + (size_t)(ki + 32) * 3072 + kc8); \
        st0 = *(const GAS v4u*)(tb_); scb0 = *(const GAS f32x4*)(cbg + seqoff + (n_) * 64 + tc8); scb1 = *(const GAS f32x4*)(cbg + seqoff + (n_) * 64 + tc8 + 4); \
        if (C.tid >= 256) { sv0 = *(const GAS v4u*)(qkv + (gr0_ + vi) * 3072 + 2048 + h * 128 + dvs * 32 + vc8); sbt = btg[seqoff + (n_) * 64 + vi]; } \
        if (C.tid < 64) sgc = gcg[seqoff + (n_) * 64 + C.tid]; } while (0)
#define SC_WRITE(buf_) do { LAS unsigned char* K_ = L + SC_K0 + (buf_) * 16384; LAS unsigned char* Q_ = L + SC_Q0 + (buf_) * 16384; \
        *(LAS v4u*)(K_ + SW256(ki, kc8 * 2)) = sk0; *(LAS v4u*)(K_ + SW256(ki + 32, kc8 * 2)) = sk1; \
        *(LAS v4u*)(Q_ + SW256(ki, kc8 * 2)) = sq0; *(LAS v4u*)(Q_ + SW256(ki + 32, kc8 * 2)) = sq1; \
        *(LAS v4u*)(L + SC_T + SW128(ti_, tc8 * 2)) = st0; { f32x4 ta_, tb2_; unpack8(st0, ta_, tb2_); *(LAS v4u*)(L + SC_T2 + SW128(ti_, tc8 * 2)) = pack8(ta_ * scb0, tb2_ * scb1); } \
        if (C.tid >= 256) { f32x4 va, vb; unpack8(sv0, va, vb); *(LAS v4u*)(L + SC_V + vi * 64 + vc8 * 2) = pack8(va * sbt, vb * sbt); } \
        if (C.tid < 64) { LAS float* sc_ = (LAS float*)(L + SC_SC0 + (buf_) * 1024); const float gl_ = __shfl(sgc, dir ? 0 : 63); sc_[C.tid] = sgc; sc_[64 + C.tid] = __expf(sgc); sc_[128 + C.tid] = __expf(gl_ - sgc); if (C.tid == 0) sc_[192] = __expf(gl_); } } while (0)
#define SC_PRODUCE_WU(kb_) do { const unsigned Kb_ = Lb + SC_K0 + (kb_) * 16384; \
        const s16x4_t k0 = tr_rd(Kb_ + SW256(8 * lq + tq, (w * 16 + 4 * tp) * 2)), k1 = tr_rd(Kb_ + SW256(8 * lq + 4 + tq, (w * 16 + 4 * tp) * 2)); \
        const s16x4_t k2 = tr_rd(Kb_ + SW256(32 + 8 * lq + tq, (w * 16 + 4 * tp) * 2)), k3 = tr_rd(Kb_ + SW256(32 + 8 * lq + 4 + tq, (w * 16 + 4 * tp) * 2)); \
        const bf16x8 ka_ = cat4(k0, k1), kb2_ = cat4(k2, k3); \
        _Pragma("unroll") for (int it = 0; it < 4; ++it) { \
            const bf16x8 bt0 = *(const LAS bf16x8*)(L + SC_T2 + SW128(it * 16 + lr, (8 * lq) * 2)), bt1 = *(const LAS bf16x8*)(L + SC_T2 + SW128(it * 16 + lr, (32 + 8 * lq) * 2)); \
            f32x4 a4 = __builtin_amdgcn_mfma_f32_16x16x32_bf16(ka_, bt0, (f32x4){0.f, 0.f, 0.f, 0.f}, 0, 0, 0); a4 = __builtin_amdgcn_mfma_f32_16x16x32_bf16(kb2_, bt1, a4, 0, 0, 0); \
            v2u pw_; pw_.x = cvtpk_c(a4[0], a4[1]); pw_.y = cvtpk_c(a4[2], a4[3]); *(LAS v2u*)(L + SC_W + SW256(it * 16 + lr, (w * 16 + 4 * lq) * 2)) = pw_; } \
        const bf16x8 at0 = *(const LAS bf16x8*)(L + SC_T + SW128(rt * 16 + lr, (8 * lq) * 2)), at1 = *(const LAS bf16x8*)(L + SC_T + SW128(rt * 16 + lr, (32 + 8 * lq) * 2)); \
        const s16x4_t v0 = tr_rd(Lb + SC_V + (8 * lq + tq) * 64 + (ct * 16 + 4 * tp) * 2), v1 = tr_rd(Lb + SC_V + (8 * lq + 4 + tq) * 64 + (ct * 16 + 4 * tp) * 2); \
        const s16x4_t v2 = tr_rd(Lb + SC_V + (32 + 8 * lq + tq) * 64 + (ct * 16 + 4 * tp) * 2), v3 = tr_rd(Lb + SC_V + (32 + 8 * lq + 4 + tq) * 64 + (ct * 16 + 4 * tp) * 2); \
        f32x4 u4 = __builtin_amdgcn_mfma_f32_16x16x32_bf16(at0, cat4(v0, v1), (f32x4){0.f, 0.f, 0.f, 0.f}, 0, 0, 0); u4 = __builtin_amdgcn_mfma_f32_16x16x32_bf16(at1, cat4(v2, v3), u4, 0, 0, 0); \
        *(LAS f32x4*)(L + SC_UT + SWU(ct * 16 + lr, rt * 4 + lq)) = u4; } while (0)
        __syncthreads();
        for (int i = C.tid; i < 8192 / 16; i += 512) *(LAS v4u*)(L + SC_ST + i * 16) = (v4u){0u, 0u, 0u, 0u};
        SC_LOAD(dir ? 63 : 0); SC_WRITE(0); SC_LOAD(dir ? 62 : 1);
        __syncthreads();
        SC_PRODUCE_WU(0);
        __syncthreads();
        for (int cc = 0; cc < 64; ++cc) {
            const int n = dir ? 63 - cc : cc, kb = cc & 1;
            LAS unsigned char* Kc = L + SC_K0 + kb * 16384; LAS unsigned char* Qc = L + SC_Q0 + kb * 16384; const LAS float* sc = (const LAS float*)(L + SC_SC0 + kb * 1024);
            const int i0 = rt * 16 + 4 * lq;
            if (!dry && cc > 0 && C.tid < 256) { const size_t grp_ = (size_t)b * SEQ + (size_t)(dir ? n + 1 : n - 1) * 64;
                *(GAS v4u*)(odir + ((size_t)dir * NTOK + grp_ + vi) * 1024 + h * 128 + dvs * 32 + vc8) = *(const LAS v4u*)(L + SC_OB + vi * 64 + vc8 * 2); }
            f32x4 accQ = {0.f, 0.f, 0.f, 0.f};
            if (!PVX(3)) {
                f32x4 accV = -*(const LAS f32x4*)(L + SC_UT + SWU(ct * 16 + lr, rt * 4 + lq));
                bf16x8 aq[4];
#pragma unroll
                for (int ks = 0; ks < 4; ++ks) { const int bo = (ks * 32 + 8 * lq) * 2; aq[ks] = *(const LAS bf16x8*)(Qc + SW256(rt * 16 + lr, bo));
                    const bf16x8 aw = *(const LAS bf16x8*)(L + SC_W + SW256(rt * 16 + lr, bo)), bs = *(const LAS bf16x8*)(L + SC_ST + SW256(ct * 16 + lr, bo));
                    accV = __builtin_amdgcn_mfma_f32_16x16x32_bf16(aw, bs, accV, 0, 0, 0); accQ = __builtin_amdgcn_mfma_f32_16x16x32_bf16(aq[ks], bs, accQ, 0, 0, 0); }
                const f32x4 di = *(const LAS f32x4*)(sc + 128 + i0); const f32x4 vn = -accV; v2u pw, qw; pw.x = cvtpk_c(vn[0], vn[1]); pw.y = cvtpk_c(vn[2], vn[3]);
                qw.x = cvtpk_c(vn[0] * di[0], vn[1] * di[1]); qw.y = cvtpk_c(vn[2] * di[2], vn[3] * di[3]);
                *(LAS v2u*)(L + SC_VT + SW128(ct * 16 + lr, i0 * 2)) = pw; *(LAS v2u*)(L + SC_VST + SW128(ct * 16 + lr, i0 * 2)) = qw;
                const float gci = sc[rt * 16 + lr]; const int ii = rt * 16 + lr;
#pragma unroll
                for (int t2 = 0; t2 < 2; ++t2) { const int jt = 2 * ct + t2; v2u iw; iw.x = 0u; iw.y = 0u;
                    if (!PVX(5) && (dir ? (jt >= rt) : (jt <= rt))) { f32x4 a4 = {0.f, 0.f, 0.f, 0.f};
#pragma unroll
                        for (int ks = 0; ks < 4; ++ks) a4 = __builtin_amdgcn_mfma_f32_16x16x32_bf16(*(const LAS bf16x8*)(Kc + SW256(jt * 16 + lr, (ks * 32 + 8 * lq) * 2)), aq[ks], a4, 0, 0, 0);
                        const f32x4 gj = *(const LAS f32x4*)(sc + jt * 16 + 4 * lq); float pv[4];
#pragma unroll
                        for (int r = 0; r < 4; ++r) { const int jj = jt * 16 + 4 * lq + r; const bool keep = (jt != rt) || (dir ? (ii <= jj) : (ii >= jj)); pv[r] = keep ? a4[r] * __expf(gci - gj[r]) : 0.f; }
                        iw.x = cvtpk_c(pv[0], pv[1]); iw.y = cvtpk_c(pv[2], pv[3]); }
                    *(LAS v2u*)(L + SC_IT + SW128(ii, (jt * 16 + 4 * lq) * 2)) = iw; } }
            if (cc + 1 < 64 && !PVX(4)) SC_WRITE(kb ^ 1);
            if (cc + 2 < 64 && !PVX(0)) SC_LOAD(dir ? 61 - cc : cc + 2);
            if (!PVX(1)) __syncthreads();
            if (!PVX(6)) {
                const bf16x8 ai0 = *(const LAS bf16x8*)(L + SC_IT + SW128(rt * 16 + lr, (8 * lq) * 2)), ai1 = *(const LAS bf16x8*)(L + SC_IT + SW128(rt * 16 + lr, (32 + 8 * lq) * 2));
                const f32x4 ei = *(const LAS f32x4*)(sc + 64 + i0);
                f32x4 accO = __builtin_amdgcn_mfma_f32_16x16x32_bf16(ai0, *(const LAS bf16x8*)(L + SC_VT + SW128(ct * 16 + lr, (8 * lq) * 2)), (f32x4){0.f, 0.f, 0.f, 0.f}, 0, 0, 0);
                accO = __builtin_amdgcn_mfma_f32_16x16x32_bf16(ai1, *(const LAS bf16x8*)(L + SC_VT + SW128(ct * 16 + lr, (32 + 8 * lq) * 2)), accO, 0, 0, 0);
                const unsigned o01 = cvtpk_c(accO[0] + ei[0] * accQ[0], accO[1] + ei[1] * accQ[1]), o23 = cvtpk_c(accO[2] + ei[2] * accQ[2], accO[3] + ei[3] * accQ[3]);
                LAS unsigned short* ob = (LAS unsigned short*)(L + SC_OB) + i0 * 32 + ct * 16 + lr;
                ob[0] = (unsigned short)(o01 & 0xffffu); ob[32] = (unsigned short)(o01 >> 16); ob[64] = (unsigned short)(o23 & 0xffffu); ob[96] = (unsigned short)(o23 >> 16); }
            if (cc + 1 < 64 && !PVX(2)) SC_PRODUCE_WU(kb ^ 1);
            if (!PVX(7)) {
                const float egl = sc[192]; const unsigned Kb = Lb + SC_K0 + kb * 16384;
                const s16x4_t k0 = tr_rd(Kb + SW256(8 * lq + tq, (w * 16 + 4 * tp) * 2)), k1 = tr_rd(Kb + SW256(8 * lq + 4 + tq, (w * 16 + 4 * tp) * 2));
                const s16x4_t k2 = tr_rd(Kb + SW256(32 + 8 * lq + tq, (w * 16 + 4 * tp) * 2)), k3 = tr_rd(Kb + SW256(32 + 8 * lq + 4 + tq, (w * 16 + 4 * tp) * 2));
                const bf16x8 ka = cat4(k0, k1), kbb = cat4(k2, k3);
#pragma unroll
                for (int c2 = 0; c2 < 2; ++c2) { accS[c2] = accS[c2] * egl;
                    accS[c2] = __builtin_amdgcn_mfma_f32_16x16x32_bf16(ka, *(const LAS bf16x8*)(L + SC_VST + SW128(c2 * 16 + lr, (8 * lq) * 2)), accS[c2], 0, 0, 0);
                    accS[c2] = __builtin_amdgcn_mfma_f32_16x16x32_bf16(kbb, *(const LAS bf16x8*)(L + SC_VST + SW128(c2 * 16 + lr, (32 + 8 * lq) * 2)), accS[c2], 0, 0, 0);
                    v2u pw; pw.x = cvtpk_c(accS[c2][0], accS[c2][1]); pw.y = cvtpk_c(accS[c2][2], accS[c2][3]);
                    *(LAS v2u*)(L + SC_ST + SW256(c2 * 16 + lr, (w * 16 + 4 * lq) * 2)) = pw; } }
            if (!PVX(1)) __syncthreads();
        }
        if (!dry && C.tid < 256) { const size_t grp_ = (size_t)b * SEQ + (size_t)(dir ? 0 : 63) * 64;
            *(GAS v4u*)(odir + ((size_t)dir * NTOK + grp_ + vi) * 1024 + h * 128 + dvs * 32 + vc8) = *(const LAS v4u*)(L + SC_OB + vi * 64 + vc8 * 2); }
#undef SC_LOAD
#undef SC_WRITE
#undef SC_PRODUCE_WU
    }
}

constexpr int N_PHASES = 16;
struct Args { const void* in[24]; float* out; unsigned char* ws; int ph_lo, ph_hi; };
__global__ void __launch_bounds__(NWAVES * 64, 2) fwd(Args args) {
    extern __shared__ __attribute__((aligned(16))) unsigned char lds[];
    Ctx C;
    C.lds = (LAS unsigned char*)lds; C.ws = args.ws; C.out = args.out;
    C.tid = threadIdx.x; C.lane = C.tid & 63; C.wave = __builtin_amdgcn_readfirstlane(C.tid >> 6); C.G = gridDim.x; C.bid = blockIdx.x;
    C.gw = C.bid * NWAVES + C.wave; C.NGW = C.G * NWAVES;
    C.x = (const float*)args.in[0]; C.c = (const float*)args.in[1]; C.positions = (const int*)args.in[2]; C.w_mod = (const float*)args.in[3]; C.b_mod = (const float*)args.in[4];
    C.g_mix = (const float*)args.in[5]; C.w_in = (const float*)args.in[6]; C.conv_w = (const float*)args.in[7]; C.a_log = (const float*)args.in[8]; C.dt_bias = (const float*)args.in[9];
    C.dn_o_gain = (const float*)args.in[10]; C.q_gain = (const float*)args.in[11]; C.w_uq = (const float*)args.in[12]; C.kv_gain = (const float*)args.in[13]; C.w_ukv = (const float*)args.in[14];
    C.w_o_dn = (const float*)args.in[15]; C.w_o_mla = (const float*)args.in[16]; C.w_out = (const float*)args.in[17]; C.g_ffn = (const float*)args.in[18]; C.w_router = (const float*)args.in[19];
    C.w_gate = (const float*)args.in[20]; C.w_up = (const float*)args.in[21]; C.w_down = (const float*)args.in[22]; C.g_final = (const float*)args.in[23];
    unsigned char* ws = args.ws;
    gu32* ctl = (gu32*)(ws + WS_CTL);
    volatile LAS unsigned* MISC = (volatile LAS unsigned*)(C.lds + MISC_OFF);
    for (int u = C.tid; u < (LDS_BYTES - LDSCTL_OFF) / 4; u += NWAVES * 64) ((LAS unsigned*)(C.lds + LDSCTL_OFF))[u] = 0u;
    __syncthreads();
    XcdBarrier bar; bar.bar = (unsigned*)(ctl + CW_BAR); bar.x = 0; bar.st = nullptr;
#if !MK_PER_PHASE
    bar = xcd_barrier_post((unsigned*)(ctl + CW_BAR), MISC + 8);
#endif
    const int lo = args.ph_lo, hi = args.ph_hi & 0xff, p5reps = 1 + ((args.ph_hi >> 8) & 1);
#ifndef PH_MASK
#define PH_MASK 0xFFFFFFFFu
#endif
#define IN(k) (((PH_MASK >> (k)) & 1u) && lo <= (k) && (k) < hi)
#ifndef PROBE_MASK
#define PROBE_MASK 0u
#endif
#define REP(k) (((PROBE_MASK >> (k)) & 1u) != 0u)
#define PHASE(k, ...) if (IN(k)) { __VA_ARGS__ if (REP(k) && !((0x637Cu >> (k)) & 1u)) { __syncthreads(); __VA_ARGS__ } }
#define NREP(k) (REP(k) ? 2 : 1)
#if MK_PER_PHASE
#define SEAM(k) do { } while (0)
#else
#define SEAM(k) do { if (IN(k) && IN((k) + 1)) xcd_barrier(bar); } while (0)
#endif
    bf16* const A_ = (bf16*)(ws + WS_A);

    PHASE(0,  p0_prologue(C); ) SEAM(0);
    PHASE(1,  p1_h(C); ) SEAM(1);
    PHASE(2,
        pg8::Gemm g{A_, (const bf16*)(ws + WS_WIN), NTOK, NPROJ, 1024}; pg8::StaticOrder S; S.init(NTOK, NPROJ, C.G, C.bid, NREP(2));
        EpiProj E{(bf16*)(ws + WS_QKV), (bf16*)(ws + WS_Z), (bf16*)(ws + WS_GATES), (bf16*)(ws + WS_CQ), (bf16*)(ws + WS_CKV), (bf16*)(ws + WS_HALO), (bf16*)(ws + WS_KROPE),
                  (float*)(ws + WS_SSQQ), (float*)(ws + WS_SSQKV), (float*)(ws + WS_BETA), (float*)(ws + WS_G), (const float*)(ws + WS_CS), C.a_log, C.dt_bias};
        pg8::gemm_phase<EpiProj, pg8::StaticOrder, true, true>(C.lds, g, S, E);
    ) SEAM(2);
    PHASE(3,
        { pg8::Gemm g{(const bf16*)(ws + WS_CQ), (const bf16*)(ws + WS_WUQ), NTOK, 1536, QL}; pg8::StaticOrder S; S.init(NTOK, 1536, C.G, C.bid, NREP(3));
          EpiQ E{A_, (const float*)(ws + WS_SSQQ), (const float*)(ws + WS_CS)};
          pg8::gemm_phase<EpiQ, pg8::StaticOrder, true, false>(C.lds, g, S, E); }
        { pg8::Gemm g{(const bf16*)(ws + WS_CKV), (const bf16*)(ws + WS_WUKV), NTOK, 2048, KVL}; KvOrder S; S.init(C.G, C.bid, NREP(3));
          EpiKV E{(bf16*)C.out, (const float*)(ws + WS_SSQKV)};
          pg8::gemm_phase<EpiKV, KvOrder, true, false>(C.lds, g, S, E); }
    ) SEAM(3);
    PHASE(4,
        const bf16* Q = A_; const bf16* KV = (const bf16*)C.out; const bf16* KR = (const bf16*)(ws + WS_KROPE); bf16* O = (bf16*)(ws + WS_OMLA);
        const int xcd = C.bid & 7, j = C.bid >> 3;
        if (C.G == 256) {
            for (int i2 = 0; i2 < 2 * NREP(4); ++i2) { const int i = i2 & 1; const int bh = i * 16 + xcd * 2 + (j >> 4), qb = j & 15, b = bh >> 3, h = bh & 7; const size_t r0 = (size_t)b * SEQ;
                att::attn_unit(Q + (r0 + qb * 256) * 1536 + h * QKD, KV + r0 * 2048 + h * 256, KV + r0 * 2048 + h * 256 + 128, KR + r0 * 64, O + (r0 + qb * 256) * 1024 + h * 128, SEQ, (char*)lds, i2 >= 2); }
        } else {
            for (int u = C.bid; u < 512; u += C.G) { const int bh = u >> 4, qb = u & 15, b = bh >> 3, h = bh & 7; const size_t r0 = (size_t)b * SEQ;
                att::attn_unit(Q + (r0 + qb * 256) * 1536 + h * QKD, KV + r0 * 2048 + h * 256, KV + r0 * 2048 + h * 256 + 128, KR + r0 * 64, O + (r0 + qb * 256) * 1024 + h * 128, SEQ, (char*)lds); }
        }
    ) SEAM(4);
    PHASE(5,  p5_chunk(C, p5reps); ) SEAM(5);
    PHASE(6,  p6_scan(C, NREP(6)); ) SEAM(6);
#ifdef PROBE_XBAR
    if (IN(6) && IN(7)) { for (int xb_ = 0; xb_ < PROBE_XBAR; ++xb_) xcd_barrier(bar); }
#endif
    PHASE(7,  p7_dnout(C); ) SEAM(7);
    PHASE(8,
        pg8::Gemm g{(const bf16*)C.out, (const bf16*)(ws + WS_WODN), NTOK, 1024, 1024, nullptr, (const bf16*)(ws + WS_OMLA), (const bf16*)(ws + WS_WOMLA)}; PairOrder S; S.init(NTOK, 1024, C.G, C.bid, NREP(8));
        EpiMixZ E{(bf16*)(ws + WS_Z), (const bf16*)(ws + WS_GATES)};
        pg8::gemm_phase<EpiMixZ, PairOrder, true, true>(C.lds, g, S, E);
    ) SEAM(8);
    PHASE(9,
        pg8::Gemm g{(const bf16*)(ws + WS_Z), (const bf16*)(ws + WS_WOUT), NTOK, 1024, 1024}; pg8::StaticOrder S; S.init(NTOK, 1024, C.G, C.bid, NREP(9));
        EpiOut E{ws, C.x, (const float*)(ws + WS_MOD)};
        pg8::gemm_phase<EpiOut, pg8::StaticOrder, true, true>(C.lds, g, S, E);
    ) SEAM(9);
    int p10var = 0;
    PHASE(10,  p11_h2(C, p10var); p10var = PROBE_VARIANT; ) SEAM(10);
    PHASE(11,  p12_topk(C); ) if (IN(11) && IN(13)) xcd_barrier(bar);
    PHASE(13,
        pg8::Gemm g{(const bf16*)(ws + WS_A), (const bf16*)(ws + WS_WGU), 64 * CAP, 16 * 2048, 1024, (const int*)(ws + WS_IDX)}; MoeOrder S; S.init(8, C.G, C.bid, NREP(13));
        EpiGU E{(bf16*)(ws + WS_HID)};
        pg8::gemm_phase<EpiGU, MoeOrder, true, true, true>(C.lds, g, S, E);
    ) SEAM(13);
    PHASE(14,
        pg8::Gemm g{(const bf16*)(ws + WS_HID), (const bf16*)(ws + WS_WD), 64 * CAP, 16 * 1024, 1024}; MoeOrder S; S.init(4, C.G, C.bid, NREP(14));
        EpiDown E{(bf16*)(ws + WS_YE), (const float*)(ws + WS_GATEW)};
        pg8::gemm_phase<EpiDown, MoeOrder, true, true>(C.lds, g, S, E);
    ) SEAM(14);
    PHASE(15,  p16_final(C); )
#undef IN
#undef SEAM
}

extern "C" void kernel_launch(void* const* d_in, const int* in_sizes, int n_in, void* d_out, int out_size, void* d_ws, size_t ws_size, hipStream_t stream) {
    static int grid = 0;
    if (grid == 0) {
        if (n_in != 24 || out_size != NTOK * DM || ws_size < WS_END) { fprintf(stderr, "kernel_launch: unexpected shapes: n_in %d out %d ws %zu (need %zu)\n", n_in, out_size, ws_size, (size_t)WS_END); grid = -1; return; }
        int dev = 0, cus = 0, per_cu = 0;
        if (hipGetDevice(&dev) != hipSuccess || hipDeviceGetAttribute(&cus, hipDeviceAttributeMultiprocessorCount, dev) != hipSuccess) { grid = -1; return; }
        if (hipFuncSetAttribute((const void*)fwd, hipFuncAttributeMaxDynamicSharedMemorySize, LDS_BYTES) != hipSuccess) { fprintf(stderr, "kernel_launch: hipFuncSetAttribute failed\n"); grid = -1; return; }
        if (hipOccupancyMaxActiveBlocksPerMultiprocessor(&per_cu, (const void*)fwd, NWAVES * 64, LDS_BYTES) != hipSuccess || per_cu < 1) fprintf(stderr, "kernel_launch: occupancy query reports %d\n", per_cu);
        (void)hipGetLastError();
        grid = cus;
    }
    if (grid < 0) return;
    if (hipMemsetAsync((char*)d_ws + WS_CTL, 0, CTL_ZERO_BYTES, stream) != hipSuccess) return;
    Args a{};
    for (int i = 0; i < 24; ++i) a.in[i] = d_in[i];
    a.out = (float*)d_out; a.ws = (unsigned char*)d_ws;
#if MK_PER_PHASE
    for (int p = 0; p < N_PHASES; ++p) { a.ph_lo = p; a.ph_hi = p + 1; hipLaunchKernelGGL(fwd, dim3(grid), dim3(NWAVES * 64), LDS_BYTES, stream, a); }
#else
    a.ph_lo = 0; a.ph_hi = N_PHASES | (((PROBE_MASK >> 5) & 1u) << 8); hipLaunchKernelGGL(fwd, dim3(grid), dim3(NWAVES * 64), LDS_BYTES, stream, a);
#endif
    const hipError_t le = hipPeekAtLastError();
    if (le != hipSuccess) fprintf(stderr, "kernel_launch: launch failed: %s\n", hipGetErrorName(le));
}
```
